# Optimizing an MI355X kernel written in HIP

```python
import math
import jax, jax.numpy as jnp
from jax import lax
import numpy as np

D_MODEL = 1024
BATCH = 2
SEQ = 8192
DEPTH = 1

MLA_HEADS = 8
MLA_NOPE = 64
MLA_ROPE = 32
MLA_V = 64
MLA_Q_RANK = 256
MLA_KV_RANK = 128
ROPE_THETA = 10000.0
DIFF_HEADS = 4
DIFF_HEAD_DIM = 64
DIFF_V = 2 * DIFF_HEAD_DIM
T5_BUCKETS = 32
T5_MAX_DIST = 128
N_EXPERTS = 32
TOP_K = 4
D_EXPERT = 1024
SWIGLU_LIMIT = 7.0
SWIGLU_ALPHA = 1.702
Q_BLOCK = 128
EXPERT_BLOCK = 128
NORM_EPS = 1e-5
NEG_INF = -1e30
OFF_KV = MLA_Q_RANK
OFF_DQ = OFF_KV + MLA_KV_RANK + MLA_ROPE
OFF_DK = OFF_DQ + DIFF_HEADS * 2 * DIFF_HEAD_DIM
OFF_DV = OFF_DK + DIFF_HEADS * 2 * DIFF_HEAD_DIM
OFF_GATE = OFF_DV + DIFF_HEADS * DIFF_V
IN_TOTAL = OFF_GATE + 2 * D_MODEL
IN_SPLITS = (OFF_KV, OFF_DQ, OFF_DK, OFF_DV, OFF_GATE)

kernel_name = "hybrid_mla_diffattn_t5_moe"


def rmsnorm(x, g):
    xf = x.astype(jnp.float32)
    y = xf * lax.rsqrt(jnp.mean(xf * xf, axis=-1, keepdims=True) + NORM_EPS)
    return (y * g.astype(jnp.float32)).astype(x.dtype)


def apply_rope(x, cos, sin):
    half = x.shape[-1] // 2
    x1, x2 = x[..., :half], x[..., half:]
    return jnp.concatenate([x1 * cos - x2 * sin, x1 * sin + x2 * cos], axis=-1).astype(x.dtype)


def to_blocks(a):
    b, s = a.shape[0], a.shape[1]
    a = a.reshape((b, s // Q_BLOCK, Q_BLOCK) + a.shape[2:])
    return jnp.moveaxis(a, 1, 0)


def from_blocks(a):
    a = jnp.moveaxis(a, 0, 1)
    return a.reshape((a.shape[0], a.shape[1] * a.shape[2]) + a.shape[3:])


def t5_bucket(q_pos, k_pos):
    n = jnp.maximum(q_pos - k_pos, 0)
    max_exact = T5_BUCKETS // 2
    nf = jnp.maximum(n, 1).astype(jnp.float32)
    large = max_exact + (jnp.log(nf / max_exact) / math.log(T5_MAX_DIST / max_exact)
                         * (T5_BUCKETS - max_exact)).astype(jnp.int32)
    large = jnp.minimum(large, T5_BUCKETS - 1)
    return jnp.where(n < max_exact, n, large)


def mla_attention(q_nope, q_rope, k_nope, k_rope, v, pos):
    scale = (MLA_NOPE + MLA_ROPE) ** -0.5

    def block(args):
        qn, qr, qp = args
        s = (jnp.einsum('bqhd,bkhd->bhqk', qn, k_nope)
             + jnp.einsum('bqhr,bkr->bhqk', qr, k_rope)).astype(jnp.float32) * scale
        causal = qp[:, :, None] >= pos[:, None, :]
        s = jnp.where(causal[:, None], s, NEG_INF)
        p = jax.nn.softmax(s, axis=-1).astype(v.dtype)
        return jnp.einsum('bhqk,bkhd->bqhd', p, v)

    out = lax.map(block, (to_blocks(q_nope), to_blocks(q_rope), to_blocks(pos)))
    return from_blocks(out)


def diff_attention(q, k, v, pos, rel_bias, lam):
    scale = DIFF_HEAD_DIM ** -0.5

    def block(args):
        qb, qp = args
        s = jnp.einsum('bqhcd,bkhcd->bhcqk', qb, k).astype(jnp.float32) * scale
        bucket = t5_bucket(qp[:, :, None], pos[:, None, :])
        bias = jnp.transpose(rel_bias[bucket], (0, 3, 1, 2)).astype(jnp.float32)
        s = s + bias[:, :, None]
        causal = qp[:, :, None] >= pos[:, None, :]
        s = jnp.where(causal[:, None, None], s, NEG_INF)
        p = jax.nn.softmax(s, axis=-1)
        a = (p[:, :, 0] - lam * p[:, :, 1]).astype(v.dtype)
        return jnp.einsum('bhqk,bkhe->bqhe', a, v)

    out = lax.map(block, (to_blocks(q), to_blocks(pos)))
    return from_blocks(out)


def clamped_swiglu(hcat):
    glu, lin = hcat[..., :D_EXPERT], hcat[..., D_EXPERT:]
    glu = jnp.minimum(glu, SWIGLU_LIMIT)
    lin = jnp.clip(lin, -SWIGLU_LIMIT, SWIGLU_LIMIT)
    return glu * jax.nn.sigmoid(SWIGLU_ALPHA * glu) * (lin + 1.0)


def moe_ffn(h, w_router, b_router, w1, b1, w2, b2):
    b, s, d = h.shape
    n = b * s
    t = h.reshape(n, d)
    logits = (t @ w_router + b_router).astype(jnp.float32)
    top_val, top_idx = lax.top_k(logits, TOP_K)
    top_w = jax.nn.softmax(top_val, axis=-1)
    nk = n * TOP_K
    flat_e = top_idx.reshape(nk)
    flat_tok = jnp.repeat(jnp.arange(n, dtype=jnp.int32), TOP_K)
    flat_w = top_w.reshape(nk)
    order = jnp.argsort(flat_e)
    se, stok, sw = flat_e[order], flat_tok[order], flat_w[order]
    counts = jnp.zeros((N_EXPERTS,), jnp.int32).at[flat_e].add(1)
    start = jnp.cumsum(counts) - counts
    padded = (counts + EXPERT_BLOCK - 1) // EXPERT_BLOCK * EXPERT_BLOCK
    pend = jnp.cumsum(padded)
    pstart = pend - padded
    dest = pstart[se] + (jnp.arange(nk, dtype=jnp.int32) - start[se])
    n_blocks = -(-nk // EXPERT_BLOCK) + N_EXPERTS
    rows = n_blocks * EXPERT_BLOCK
    row_tok = jnp.full((rows,), n, jnp.int32).at[dest].set(stok)
    row_w = jnp.zeros((rows,), jnp.float32).at[dest].set(sw)
    block_e = jnp.minimum(
        jnp.searchsorted(pend, jnp.arange(n_blocks, dtype=jnp.int32) * EXPERT_BLOCK, side='right'),
        N_EXPERTS - 1).astype(jnp.int32)
    t_pad = jnp.concatenate([t, jnp.zeros((1, d), t.dtype)], axis=0)
    xs = t_pad[row_tok].reshape(n_blocks, EXPERT_BLOCK, d)

    def expert_block(args):
        xb, e = args
        act = clamped_swiglu(xb @ w1[e] + b1[e])
        return act @ w2[e] + b2[e]

    ys = lax.map(expert_block, (xs, block_e)).reshape(rows, d)
    ys = ys * row_w[:, None].astype(ys.dtype)
    out = jax.ops.segment_sum(ys, row_tok, num_segments=n + 1)[:n]
    return out.reshape(b, s, d)


def hybrid_layer(x, pos, cos, sin, rel_bias, lambda_init, norm_mix, w_in, mla_q_norm, w_q_b,
                 mla_kv_norm, w_kv_b, diff_lambda, diff_subln, w_up_mla, w_up_diff, w_out,
                 norm_ffn, w_router, b_router, w1, b1, w2, b2):
    b, s, _ = x.shape
    h = rmsnorm(x, norm_mix)
    proj = h @ w_in
    q_a, kv_a, dq, dk, dv, gates = jnp.split(proj, IN_SPLITS, axis=-1)

    q = (rmsnorm(q_a, mla_q_norm) @ w_q_b).reshape(b, s, MLA_HEADS, MLA_NOPE + MLA_ROPE)
    q_nope, q_rope = q[..., :MLA_NOPE], q[..., MLA_NOPE:]
    c_kv, k_rope = kv_a[..., :MLA_KV_RANK], kv_a[..., MLA_KV_RANK:]
    kv = (rmsnorm(c_kv, mla_kv_norm) @ w_kv_b).reshape(b, s, MLA_HEADS, MLA_NOPE + MLA_V)
    k_nope, v_mla = kv[..., :MLA_NOPE], kv[..., MLA_NOPE:]
    q_rope = apply_rope(q_rope, cos[:, :, None], sin[:, :, None])
    k_rope = apply_rope(k_rope, cos, sin)
    y_mla = mla_attention(q_nope, q_rope, k_nope, k_rope, v_mla, pos).reshape(b, s, MLA_HEADS * MLA_V)

    q_d = dq.reshape(b, s, DIFF_HEADS, 2, DIFF_HEAD_DIM)
    k_d = dk.reshape(b, s, DIFF_HEADS, 2, DIFF_HEAD_DIM)
    v_d = dv.reshape(b, s, DIFF_HEADS, DIFF_V)
    lf = diff_lambda.astype(jnp.float32)
    lam = (jnp.exp(jnp.sum(lf[0] * lf[1])) - jnp.exp(jnp.sum(lf[2] * lf[3])) + lambda_init)
    y_diff = diff_attention(q_d, k_d, v_d, pos, rel_bias, lam)
    y_diff = (rmsnorm(y_diff, diff_subln) * (1.0 - lambda_init)).reshape(b, s, DIFF_HEADS * DIFF_V)

    g = jax.nn.sigmoid(gates.astype(jnp.float32)).astype(x.dtype)
    g_mla, g_diff = g[..., :D_MODEL], g[..., D_MODEL:]
    merged = g_mla * (y_mla @ w_up_mla) + g_diff * (y_diff @ w_up_diff)
    x = x + merged @ w_out

    x = x + moe_ffn(rmsnorm(x, norm_ffn), w_router, b_router, w1, b1, w2, b2)
    return x


def setup_inputs(seed: int = 0) -> dict:
    key = jax.random.key(seed)
    ks = jax.random.split(key, 24)
    f32 = jnp.float32

    def nrm(k, shape, scale):
        return jax.random.normal(k, shape, f32) * scale

    mla_q_out = MLA_HEADS * (MLA_NOPE + MLA_ROPE)
    mla_kv_out = MLA_HEADS * (MLA_NOPE + MLA_V)
    x = jax.random.normal(ks[0], (BATCH, SEQ, D_MODEL), f32)
    offset = jax.random.randint(ks[1], (BATCH, 1), 0, 4096, dtype=jnp.int32)
    positions = (offset + jnp.arange(SEQ, dtype=jnp.int32)[None, :]).astype(jnp.int32)
    return {
        "x": x,
        "positions": positions,
        "norm_mix": 1.0 + nrm(ks[2], (DEPTH, D_MODEL), 0.02),
        "w_in": nrm(ks[3], (DEPTH, D_MODEL, IN_TOTAL), D_MODEL ** -0.5),
        "mla_q_norm": 1.0 + nrm(ks[4], (DEPTH, MLA_Q_RANK), 0.02),
        "w_q_b": nrm(ks[5], (DEPTH, MLA_Q_RANK, mla_q_out), MLA_Q_RANK ** -0.5),
        "mla_kv_norm": 1.0 + nrm(ks[6], (DEPTH, MLA_KV_RANK), 0.02),
        "w_kv_b": nrm(ks[7], (DEPTH, MLA_KV_RANK, mla_kv_out), MLA_KV_RANK ** -0.5),
        "diff_lambda": nrm(ks[8], (DEPTH, 4, DIFF_HEAD_DIM), 0.1),
        "diff_subln": 1.0 + nrm(ks[9], (DEPTH, DIFF_V), 0.02),
        "rel_bias": nrm(ks[10], (T5_BUCKETS, DIFF_HEADS), 0.5),
        "w_up_mla": nrm(ks[11], (DEPTH, MLA_HEADS * MLA_V, D_MODEL), (MLA_HEADS * MLA_V) ** -0.5),
        "w_up_diff": nrm(ks[12], (DEPTH, DIFF_HEADS * DIFF_V, D_MODEL), (DIFF_HEADS * DIFF_V) ** -0.5),
        "w_out": nrm(ks[13], (DEPTH, D_MODEL, D_MODEL), D_MODEL ** -0.5),
        "norm_ffn": 1.0 + nrm(ks[14], (DEPTH, D_MODEL), 0.02),
        "w_router": nrm(ks[15], (DEPTH, D_MODEL, N_EXPERTS), D_MODEL ** -0.5),
        "b_router": nrm(ks[16], (DEPTH, N_EXPERTS), 0.01),
        "w1": nrm(ks[17], (DEPTH, N_EXPERTS, D_MODEL, 2 * D_EXPERT), D_MODEL ** -0.5),
        "b1": nrm(ks[18], (DEPTH, N_EXPERTS, 2 * D_EXPERT), 0.02),
        "w2": nrm(ks[19], (DEPTH, N_EXPERTS, D_EXPERT, D_MODEL), D_EXPERT ** -0.5),
        "b2": nrm(ks[20], (DEPTH, N_EXPERTS, D_MODEL), 0.02),
        "norm_final": 1.0 + nrm(ks[21], (D_MODEL,), 0.02),
    }


def reference(x, positions, norm_mix, w_in, mla_q_norm, w_q_b, mla_kv_norm, w_kv_b, diff_lambda,
              diff_subln, rel_bias, w_up_mla, w_up_diff, w_out, norm_ffn, w_router, b_router,
              w1, b1, w2, b2, norm_final):
    freqs = ROPE_THETA ** (-jnp.arange(0, MLA_ROPE, 2, dtype=jnp.float32) / MLA_ROPE)
    ang = positions.astype(jnp.float32)[..., None] * freqs
    cos, sin = jnp.cos(ang).astype(x.dtype), jnp.sin(ang).astype(x.dtype)
    for l in range(DEPTH):
        lambda_init = 0.8 - 0.6 * math.exp(-0.3 * l)
        x = hybrid_layer(x, positions, cos, sin, rel_bias, lambda_init, norm_mix[l], w_in[l],
                         mla_q_norm[l], w_q_b[l], mla_kv_norm[l], w_kv_b[l], diff_lambda[l],
                         diff_subln[l], w_up_mla[l], w_up_diff[l], w_out[l], norm_ffn[l],
                         w_router[l], b_router[l], w1[l], b1[l], w2[l], b2[l])
    return rmsnorm(x, norm_final)
```

```cpp
#include <hip/hip_runtime.h>
#include <hip/hip_bf16.h>
#include <cstdio>
#include <cstdint>
#include <cmath>

#ifndef MK_N_LAUNCHES
#define MK_N_LAUNCHES 1
#endif

namespace pg8 {
#define PG8_LAS __attribute__((address_space(3)))
typedef unsigned short bf16_t;
typedef short bf16x8 __attribute__((ext_vector_type(8)));
typedef float f32x4 __attribute__((ext_vector_type(4)));
typedef unsigned u32x4 __attribute__((ext_vector_type(4)));
typedef unsigned u32x2 __attribute__((ext_vector_type(2)));
constexpr int BM = 256, BK = 64, HALF = 128, HTB = HALF * BK * 2  , STAGE_BYTES = 8 * HTB, NXCD = 8, WGM = 8;

__host__ __device__ __forceinline__ int lds_byte(int r, int c) { const int st = (r >> 4) * 2 + (c >> 5), rr = r & 15, cc = c & 31, ob = rr * 64 + cc * 2; return st * 1024 + (ob ^ (((ob >> 9) & 1) << 5)); }
__host__ __device__ __forceinline__ void stage_rc(int b, int& R, int& C) { const int st = b / 1024, sb = b % 1024, swz = sb ^ (((sb >> 9) & 1) << 5); R = (st >> 1) * 16 + swz / 64; C = (st & 1) * 32 + (swz % 64) / 2; }
__host__ __device__ __forceinline__ int perm32(int rho) { const int n = rho >> 4, i = rho & 15; return 8 * (i >> 2) + 4 * n + (i & 3); }

struct Unit { int pm, pn, e, rt, ord; };

struct StaticOrder {
    int nM, nN, nwg, G, c;
    __host__ __device__ void init(int M, int N, int G_, int c_) { nM = M / BM; nN = N / BM; nwg = nM * nN; G = G_; c = c_; }
    __host__ __device__ bool next(int i, Unit& u) const {
        const long L = (long)i * G + c; if (L >= nwg) return false;
        int wgid = (int)L; { const int q = nwg / NXCD, r = nwg % NXCD, xcd = wgid % NXCD, off = wgid / NXCD; wgid = (xcd < r ? xcd * (q + 1) : r * (q + 1) + (xcd - r) * q) + off; }
        const int nig = WGM * nN, gid = wgid / nig, fm = gid * WGM, gsz = (nM - fm) < WGM ? (nM - fm) : WGM;
        u.pm = fm + ((wgid % nig) % gsz); u.pn = (wgid % nig) / gsz; u.e = 0; u.rt = 0; u.ord = i; return true;
    }
};

typedef float f32x2_cv __attribute__((ext_vector_type(2))); typedef __bf16 bf16x2_cv __attribute__((ext_vector_type(2)));
__device__ __forceinline__ unsigned cvt_pk_bf16(float lo, float hi) { const f32x2_cv v = {lo, hi}; const bf16x2_cv b = __builtin_convertvector(v, bf16x2_cv); return __builtin_bit_cast(unsigned, b); }

template <class E, class = void> struct epi_has_mid { static constexpr bool value = false; };
template <class E> struct epi_has_mid<E, decltype((void)E::HAS_MID)> { static constexpr bool value = true; };
template <class E, class = void> struct epi_has_pre { static constexpr bool value = false; };
template <class E> struct epi_has_pre<E, decltype((void)E::HAS_PRE)> { static constexpr bool value = true; };
template <class P, class = void> struct prob_is_fp8 { static constexpr bool value = false; };
template <class P> struct prob_is_fp8<P, decltype((void)P::FP8)> { static constexpr bool value = true; };
typedef int v8i_t __attribute__((ext_vector_type(8)));
typedef int v4i_t __attribute__((ext_vector_type(4)));
__device__ __forceinline__ v8i_t join8(const bf16x8& lo, const bf16x8& hi) { const v4i_t a = __builtin_bit_cast(v4i_t, lo), b = __builtin_bit_cast(v4i_t, hi); return __builtin_shufflevector(a, b, 0, 1, 2, 3, 4, 5, 6, 7); }
template <class Epi, class Sched, class Prob, bool NOMMA = false>
__device__ __forceinline__ void gemm_phase(PG8_LAS unsigned char* lds, const Prob& P, const Sched& S, const Epi& E) {
    int tid = threadIdx.x; asm volatile("" : "+v"(tid));
    const int wid = __builtin_amdgcn_readfirstlane(tid >> 6), lane = tid & 63, wr = wid >> 2, wc = wid & 3, fr = lane & 15, fq = lane >> 4;
    const int K = P.K, nt = K / BK;
    int Ra[2], Ca[2]; unsigned voffB[2];
#pragma unroll
    for (int i = 0; i < 2; ++i) { int R, C; stage_rc(tid * 16 + i * 8192, R, C); const int Rb = (R & ~31) + perm32(R & 31);
        Ra[i] = R; Ca[i] = C * 2; voffB[i] = (unsigned)(Rb * P.ldb + C) * 2u; }
    const size_t kstep = (size_t)(BK * 2);
    const size_t hstepB = (size_t)HALF * P.ldb * 2;
    const unsigned ldsw = (unsigned)wid * 1024u;
    constexpr bool F8 = prob_is_fp8<Prob>::value;
    constexpr int KOFF = F8 ? 16 : 1024;
    const int aoff = lds_byte(wr * 64 + fr, F8 ? fq * 16 : fq * 8), boff = lds_byte(wc * 32 + fr, F8 ? fq * 16 : fq * 8);
#define PG8_SA(b, h) (((b) * 2 + (h)) * HTB)
#define PG8_SB(b, h) ((4 + (b) * 2 + (h)) * HTB)
#define PG8_STAGE(bufoff, gbase, voff) do { _Pragma("unroll") for (int _i = 0; _i < 2; ++_i) \
        __builtin_amdgcn_global_load_lds((const unsigned*)((const char*)(gbase) + (voff)[_i]), (PG8_LAS unsigned*)(lds + (bufoff) + ldsw + _i * 8192), 16, 0, 0); } while (0)
#define PG8_LDA(dst, b, h) do { _Pragma("unroll") for (int m = 0; m < 4; ++m) { const v4i_t lo_ = *(const PG8_LAS v4i_t*)(lds + PG8_SA(b, h) + aoff + m * 2048), hi_ = *(const PG8_LAS v4i_t*)(lds + PG8_SA(b, h) + aoff + m * 2048 + KOFF); \
        dst[m] = __builtin_shufflevector(lo_, hi_, 0, 1, 2, 3, 4, 5, 6, 7); } } while (0)
#define PG8_LDB(dst, b, h) do { _Pragma("unroll") for (int n = 0; n < 2; ++n) { const v4i_t lo_ = *(const PG8_LAS v4i_t*)(lds + PG8_SB(b, h) + boff + n * 2048), hi_ = *(const PG8_LAS v4i_t*)(lds + PG8_SB(b, h) + boff + n * 2048 + KOFF); \
        dst[n] = __builtin_shufflevector(lo_, hi_, 0, 1, 2, 3, 4, 5, 6, 7); } } while (0)
#define PG8_LO(x) __builtin_bit_cast(bf16x8, __builtin_shufflevector(x, x, 0, 1, 2, 3))
#define PG8_HI(x) __builtin_bit_cast(bf16x8, __builtin_shufflevector(x, x, 4, 5, 6, 7))
#define PG8_MMA(FIRST, ai, bj, At, Bt) do { __builtin_amdgcn_s_setprio(1); if constexpr (!NOMMA) { \
        if constexpr (F8) { _Pragma("unroll") for (int m = 0; m < 4; ++m) _Pragma("unroll") for (int n = 0; n < 2; ++n) {   \
            if constexpr (FIRST) asm volatile("v_mfma_scale_f32_16x16x128_f8f6f4 %0, %1, %2, 0, %3, %3 op_sel_hi:[0,0,0]" : "=&v"(acc[ai][bj][m][n]) : "v"(Bt[n]), "v"(At[m]), "v"(sc8)); \
            else asm volatile("v_mfma_scale_f32_16x16x128_f8f6f4 %0, %1, %2, %0, %3, %3 op_sel_hi:[0,0,0]" : "+v"(acc[ai][bj][m][n]) : "v"(Bt[n]), "v"(At[m]), "v"(sc8)); } } \
        else {   \
            _Pragma("unroll") for (int m = 0; m < 4; ++m) _Pragma("unroll") for (int n = 0; n < 2; ++n) { \
                if constexpr (FIRST) asm volatile("v_mfma_f32_16x16x32_bf16 %0, %1, %2, 0" : "=&v"(acc[ai][bj][m][n]) : "v"(PG8_LO(Bt[n])), "v"(PG8_LO(At[m]))); \
                else asm volatile("v_mfma_f32_16x16x32_bf16 %0, %1, %2, %0" : "+v"(acc[ai][bj][m][n]) : "v"(PG8_LO(Bt[n])), "v"(PG8_LO(At[m]))); } \
            _Pragma("unroll") for (int m = 0; m < 4; ++m) _Pragma("unroll") for (int n = 0; n < 2; ++n) \
                asm volatile("v_mfma_f32_16x16x32_bf16 %0, %1, %2, %0" : "+v"(acc[ai][bj][m][n]) : "v"(PG8_HI(Bt[n])), "v"(PG8_HI(At[m]))); } } \
        __builtin_amdgcn_s_setprio(0); } while (0)
#define PG8_WAIT_V(n) asm volatile("s_waitcnt vmcnt(" #n ")" ::: "memory")
#define PG8_WAIT_L(n) asm volatile("s_waitcnt lgkmcnt(" #n ")" ::: "memory")
#define PG8_BAR __builtin_amdgcn_s_barrier()
#define PG8_SCHED __builtin_amdgcn_sched_barrier(0)
#define PG8_AOFF(dst, u) do { _Pragma("unroll") for (int _h = 0; _h < 2; ++_h) _Pragma("unroll") for (int _i = 0; _i < 2; ++_i) { dst[_h][_i] = P.a_off(u, _h * HALF + Ra[_i]) + (unsigned)Ca[_i]; asm volatile("" : "+v"(dst[_h][_i])); } } while (0)
    Unit cur, nxt; int ui = 0;
    if (!S.next(0, cur)) return;
    f32x4 acc[2][2][4][2];
#define PG8_ZERO_ACC do { _Pragma("unroll") for (int a = 0; a < 2; ++a) _Pragma("unroll") for (int b = 0; b < 2; ++b) _Pragma("unroll") for (int m = 0; m < 4; ++m) _Pragma("unroll") for (int n = 0; n < 2; ++n) acc[a][b][m][n] = (f32x4){0.f, 0.f, 0.f, 0.f}; } while (0)
    const int sc8 = 0x7F7F7F7F;
    v8i_t At[4], B0[2], B1[2];
    unsigned cvA[2][2], nvA[2][2];
    PG8_AOFF(cvA, cur);
    const char* const cA = P.a_base(); const char* cB = P.b_base(cur);
    PG8_STAGE(PG8_SB(0, 0), cB, voffB); PG8_STAGE(PG8_SB(0, 1), cB + hstepB, voffB); PG8_STAGE(PG8_SA(0, 0), cA, cvA[0]); PG8_STAGE(PG8_SA(0, 1), cA, cvA[1]);
    if (wr == 1) PG8_BAR;
    PG8_WAIT_V(2); PG8_BAR;
    PG8_STAGE(PG8_SB(1, 0), cB + kstep, voffB); PG8_STAGE(PG8_SA(1, 0), cA + kstep, cvA[0]); PG8_STAGE(PG8_SB(1, 1), cB + hstepB + kstep, voffB);
    PG8_WAIT_V(6); PG8_BAR;
    for (;;) {
        const bool has_next = S.next(ui + 1, nxt);
        const char* nB = cB;
        if (has_next) { nB = P.b_base(nxt); PG8_AOFF(nvA, nxt); }
        else {
#pragma unroll
            for (int _h = 0; _h < 2; ++_h)
#pragma unroll
                for (int _i = 0; _i < 2; ++_i) nvA[_h][_i] = cvA[_h][_i];
        }
        if constexpr (epi_has_pre<Epi>::value) E.pre(cur, wid, lane);
#define PG8_KITER(FIRST) do { \
            if constexpr (!(FIRST) && epi_has_mid<Epi>::value) { if (t == nt / 2) { asm volatile("s_nop 15\n\ts_nop 3" ::: "memory"); E.mid(acc, cur, wr, wc, fr, fq); } }        \
            const bool last = (t == nt - 2); \
            const char* a1 = cA + (size_t)(t + 1) * kstep;                                             \
            const char* a2 = last ? cA : cA + (size_t)(t + 2) * kstep; const char* b2 = last ? nB : cB + (size_t)(t + 2) * kstep;     \
            const char* a3 = a2 + kstep; const char* b3 = b2 + kstep;                                \
            unsigned xv0[2], xv1[2];                                                                \
            _Pragma("unroll") for (int _i = 0; _i < 2; ++_i) { xv0[_i] = last ? nvA[0][_i] : cvA[0][_i]; xv1[_i] = last ? nvA[1][_i] : cvA[1][_i]; } \
              \
            PG8_LDB(B0, 0, 0); PG8_LDB(B1, 0, 1); PG8_SCHED; PG8_LDA(At, 0, 0); PG8_STAGE(PG8_SA(1, 1), a1, cvA[1]); \
            PG8_WAIT_V(8); PG8_WAIT_L(0); PG8_BAR; PG8_MMA(FIRST, 0, 0, At, B0); PG8_MMA(FIRST, 0, 1, At, B1); PG8_BAR; PG8_SCHED; \
              \
            PG8_LDA(At, 0, 1); PG8_STAGE(PG8_SB(0, 0), b2, voffB); PG8_STAGE(PG8_SB(0, 1), b2 + hstepB, voffB); PG8_STAGE(PG8_SA(0, 0), a2, xv0); \
            PG8_WAIT_V(8); PG8_WAIT_L(0); PG8_BAR; PG8_MMA(FIRST, 1, 0, At, B0); PG8_MMA(FIRST, 1, 1, At, B1); PG8_BAR; PG8_SCHED; \
              \
            PG8_LDB(B0, 1, 0); PG8_LDB(B1, 1, 1); PG8_SCHED; PG8_LDA(At, 1, 0); PG8_STAGE(PG8_SA(0, 1), a2, xv1); \
            PG8_WAIT_V(8); PG8_WAIT_L(0); PG8_BAR; PG8_MMA(false, 0, 0, At, B0); PG8_MMA(false, 0, 1, At, B1); PG8_BAR; PG8_SCHED; \
              \
            PG8_LDA(At, 1, 1); PG8_STAGE(PG8_SB(1, 0), b3, voffB); PG8_STAGE(PG8_SB(1, 1), b3 + hstepB, voffB); PG8_STAGE(PG8_SA(1, 0), a3, xv0); \
            PG8_WAIT_V(8); PG8_WAIT_L(0); PG8_BAR; PG8_MMA(false, 1, 0, At, B0); PG8_MMA(false, 1, 1, At, B1); PG8_BAR; PG8_SCHED; \
        } while (0)
        { const int t = 0; PG8_KITER(true); }
        for (int t = 2; t < nt; t += 2) { PG8_KITER(false); }
#undef PG8_KITER
        if (wr == 0) PG8_BAR;
        asm volatile("s_nop 15\n\ts_nop 3" ::: "memory");
        E(acc, cur, wr, wc, fr, fq);
#ifdef PG8_DUP_EPI
        E(acc, cur, wr, wc, fr, fq);
#endif
        if (!has_next) break;
        cur = nxt; cB = nB; ++ui;
#pragma unroll
        for (int _h = 0; _h < 2; ++_h)
#pragma unroll
            for (int _i = 0; _i < 2; ++_i) cvA[_h][_i] = nvA[_h][_i];
        if (wr == 1) PG8_BAR;
    }
    PG8_WAIT_V(0);
    PG8_BAR;
#undef PG8_SA
#undef PG8_SB
#undef PG8_STAGE
#undef PG8_LDA
#undef PG8_LDB
#undef PG8_LO
#undef PG8_HI
#undef PG8_MMA
#undef PG8_WAIT_V
#undef PG8_WAIT_L
#undef PG8_BAR
#undef PG8_SCHED
#undef PG8_AOFF
#undef PG8_ZERO_ACC
}
}

#define GAS __attribute__((address_space(1)))
#define LAS __attribute__((address_space(3)))
typedef unsigned short bf16;
typedef unsigned v4u __attribute__((ext_vector_type(4)));
typedef unsigned v2u __attribute__((ext_vector_type(2)));
typedef float f32x4 __attribute__((ext_vector_type(4)));
typedef float f32x2 __attribute__((ext_vector_type(2)));
typedef GAS unsigned gu32;
#define RLX_AGENT __ATOMIC_RELAXED, __HIP_MEMORY_SCOPE_AGENT
#define LDS_WAIT() asm volatile("s_waitcnt lgkmcnt(0)" ::: "memory")
#define VM_WAIT() asm volatile("s_waitcnt vmcnt(0)" ::: "memory")
__device__ __forceinline__ unsigned f2bf(float f) { unsigned u = __builtin_bit_cast(unsigned, f); return (u + 0x7fffu + ((u >> 16) & 1u)) >> 16; }
__device__ __forceinline__ unsigned pk2(float lo, float hi) { return f2bf(lo) | (f2bf(hi) << 16); }
__device__ __forceinline__ float bf2f(unsigned h) { return __builtin_bit_cast(float, h << 16); }
__device__ __forceinline__ float wave_sum(float v) {
#pragma unroll
    for (int o = 1; o < 64; o <<= 1) v += __shfl_xor(v, o);
    return v;
}

constexpr int NWAVES = 8;
constexpr int NTOK = 16384, SEQ = 8192, DM = 1024, NPROJ = 4096, NE = 32, INT_TOTAL = 4000;
constexpr float EPS = 1e-5f, LOG2E = 1.4426950408889634f;
constexpr float C2D = 0.125f * LOG2E;
constexpr float C2M = 0.10206207261596577f * LOG2E;
constexpr float W8_SCALE = 32.0f;
constexpr float X8_SCALE = 16.0f;
constexpr float H8_SCALE = 4.0f;
constexpr float Y8_SCALE = 16.0f;
constexpr int HCAP = 73728;

constexpr size_t MiB = 1u << 20, KiB = 1u << 10;
constexpr size_t WS_CTL = 0, CTL_ZERO_BYTES = 32 * KiB;
constexpr size_t WS_WQ = 1 * MiB, WS_WKV = 1 * MiB + 512 * KiB, WS_WUP = 2 * MiB, WS_WOUT = 4 * MiB, WS_WR = 6 * MiB, WS_RX = 6 * MiB + 256 * KiB;
constexpr size_t WS_SSQQ = 6 * MiB + 512 * KiB, WS_SSQKV = 6 * MiB + 768 * KiB, WS_SSQ2 = 7 * MiB, WS_WIN = 8 * MiB, WS_CS = 16 * MiB, WS_TOKL = 18 * MiB;
constexpr size_t WS_SEL = 20 * MiB, WS_WTS = 20 * MiB + 256 * KiB, WS_R2 = 20 * MiB + 512 * KiB, WS_KR = 21 * MiB;
constexpr size_t WS_W1T = 24 * MiB, WS_W2T = 152 * MiB, WS_XB = 216 * MiB, WS_PROJ = 248 * MiB, WS_QM = 376 * MiB, WS_KN = 400 * MiB, WS_VM = 416 * MiB;
constexpr size_t WS_YC = 432 * MiB, WS_OD = 464 * MiB, WS_T1 = 496 * MiB, WS_MG = 528 * MiB, WS_X1 = 560 * MiB, WS_X1B = 624 * MiB, WS_YB = 656 * MiB, WS_END = 800 * MiB;
constexpr size_t WS_XQ = WS_X1B;
constexpr size_t WS_XB8 = WS_X1B + 16 * MiB;
constexpr size_t WS_WING8 = WS_WIN + 4 * MiB;
constexpr size_t WS_HB = WS_PROJ;
static_assert(WS_HB + (size_t)HCAP * 1024 * 2 <= WS_KN, "HB overlay");
constexpr int CW_TMO = 0, CW_GCNT = 64  , CW_BAR = 4096;

constexpr int RING_OFF = 0, RING_BYTES = 131072;
constexpr int CONV_OFF = 125440;
constexpr int LDSCTL_OFF = 155 * 1024, MISC_OFF = LDSCTL_OFF + 320;
constexpr int TAB_OFF = LDSCTL_OFF + 1024;
constexpr int EPI_TAB_OFF = 140 * 1024;
constexpr int LDS_BYTES = 163840;
#define XB_TMO      128
#define XB_XCNT(j)  (256  + 64 * (j))
#define XB_XSUB(j)  (1280 + 64 * (j))
#define XB_XGEN(j)  (2304 + 64 * (j))
#define XB_TOP      3328
#define XB_TOPGEN   3392
#define XCD_BAR_WORDS 3456
#define XB_SPIN_CAP (1u << 18)

__device__ __forceinline__ unsigned xb_ld(unsigned* p)              { return __hip_atomic_load(p, __ATOMIC_RELAXED, __HIP_MEMORY_SCOPE_AGENT); }
__device__ __forceinline__ unsigned xb_add(unsigned* p, unsigned v) { return __hip_atomic_fetch_add(p, v, __ATOMIC_RELAXED, __HIP_MEMORY_SCOPE_AGENT); }
__device__ __forceinline__ unsigned xb_xcc_id() { return (unsigned)__builtin_amdgcn_s_getreg((3 << 11) | 20) & 0xFu; }
#define XB_SPIN(cond, bar) do { unsigned _sp = 0; while (cond) { __builtin_amdgcn_s_sleep(1); \
    if ((++_sp & 255u) == 0u) { if (xb_ld(&(bar)[XB_TMO])) break; if (_sp > XB_SPIN_CAP) { atomicAdd(&(bar)[XB_TMO], 1u); break; } } } } while (0)

struct XcdBarrier {
    unsigned* bar; unsigned x;
    volatile LAS unsigned* st;
};

__device__ __forceinline__ XcdBarrier xcd_barrier_post(unsigned* bar, volatile LAS unsigned* st) {
    XcdBarrier b; b.bar = bar; b.x = xb_xcc_id(); b.st = st;
    if (threadIdx.x == 0) (void)xb_add(&bar[XB_XCNT(b.x)], 1u);
    return b;
}
__device__ __forceinline__ void xcd_barrier_complete(unsigned* bar, unsigned x, unsigned& nloc, unsigned& nx) {
    const unsigned G = gridDim.x * gridDim.y * gridDim.z;
    unsigned sum, cnt, mine, sp = 0u;
    for (;;) {
        sum = 0u; cnt = 0u; mine = 0u;
#pragma unroll
        for (unsigned j = 0; j < 16; ++j) { const unsigned c = xb_ld(&bar[XB_XCNT(j)]); sum += c; cnt += (c > 0u) ? 1u : 0u; mine = (j == x) ? c : mine; }
        if (sum == G) break;
        __builtin_amdgcn_s_sleep(1);
        if ((++sp & 255u) == 0u) { if (xb_ld(&bar[XB_TMO])) break; if (sp > XB_SPIN_CAP) { atomicAdd(&bar[XB_TMO], 1u); break; } }
    }
    nloc = mine > 0u ? mine : 1u; nx = cnt > 0u ? cnt : 1u;
}

__device__ __forceinline__ void xcd_barrier(const XcdBarrier& b) {
    asm volatile("s_waitcnt vmcnt(0)" ::: "memory");
    __syncthreads();
    if (threadIdx.x == 0) {
        unsigned* bar = b.bar;
        __builtin_amdgcn_s_waitcnt(0);
        unsigned nloc = b.st[0], nx = b.st[1];
        if (nloc == 0u) { xcd_barrier_complete(bar, b.x, nloc, nx); b.st[0] = nloc; b.st[1] = nx; }
        const unsigned old = xb_add(&bar[XB_XSUB(b.x)], 1u);
        const unsigned gen = old / nloc;
        if (old + 1u == (gen + 1u) * nloc) {
            __builtin_amdgcn_fence(__ATOMIC_RELEASE, "agent");
            asm volatile("s_waitcnt vmcnt(0)" ::: "memory");
            const unsigned og = xb_add(&bar[XB_TOP], 1u);
            const unsigned tg = og / nx;
            if (og + 1u == (tg + 1u) * nx) xb_add(&bar[XB_TOPGEN], 1u);
            else XB_SPIN(xb_ld(&bar[XB_TOPGEN]) == tg, bar);
            __builtin_amdgcn_fence(__ATOMIC_ACQUIRE, "agent");
            xb_add(&bar[XB_XGEN(b.x)], 1u);
            asm volatile("s_waitcnt vmcnt(0)" ::: "memory");
        } else {
            XB_SPIN(xb_ld(&bar[XB_XGEN(b.x)]) == gen, bar);
            __builtin_amdgcn_fence(__ATOMIC_ACQUIRE, "agent");
            asm volatile("s_waitcnt vmcnt(0)" ::: "memory");
        }
    }
    __syncthreads();
}

struct Args {
    const float* x; const int* pos; const float* norm_mix; const float* w_in; const float* mla_q_norm; const float* w_q_b; const float* mla_kv_norm; const float* w_kv_b;
    const float* diff_lambda; const float* diff_subln; const float* rel_bias; const float* w_up_mla; const float* w_up_diff; const float* w_out; const float* norm_ffn;
    const float* w_router; const float* b_router; const float* w1; const float* b1; const float* w2; const float* b2; const float* norm_final;
    float* out; unsigned char* ws; int ph_lo, ph_hi;
};

__device__ __forceinline__ int rope_dim(int p) { return 16 * ((p >> 2) & 1) + 4 * (p >> 3) + (p & 3); }

__device__ __forceinline__ unsigned pk4_fp8(float a, float b, float c, float d) { int w = __builtin_amdgcn_cvt_pk_fp8_f32(a, b, 0, false); w = __builtin_amdgcn_cvt_pk_fp8_f32(c, d, w, true); return (unsigned)w; }
template <bool OUT8, class Map>
__device__ __forceinline__ void tr_item(const float* src, int lds_, int Ksrc, void* dstv, int ldd, int koff, const Map& map, LAS float* scr, int kb, int nb, int lane) {
    const int k0 = 64 * kb, n0 = 64 * nb, c = lane & 15, kq = lane >> 4;
    const int col = map.col(n0 + 4 * c);
    f32x4 v[16];
#pragma unroll
    for (int j = 0; j < 16; ++j) { const int k = k0 + 4 * j + kq; v[j] = (f32x4){0.f, 0.f, 0.f, 0.f};
        if (col >= 0 && k < Ksrc) v[j] = *(const GAS f32x4*)(src + (size_t)k * lds_ + col); }
#pragma unroll
    for (int j = 0; j < 16; ++j) { const int k = k0 + 4 * j + kq; const float sc = (k < Ksrc) ? map.scale(k) : 0.f;
#pragma unroll
        for (int i = 0; i < 4; ++i) scr[(4 * c + i) * 65 + 4 * j + kq] = v[j][i] * sc; }
    LDS_WAIT(); asm volatile("" ::: "memory");
    const int cc = lane & 7;
#pragma unroll
    for (int jj = 0; jj < 8; ++jj) { const int n = (lane >> 3) + 8 * jj; const LAS float* s = scr + n * 65 + 8 * cc;
        if constexpr (OUT8) { v2u o; o.x = pk4_fp8(s[0], s[1], s[2], s[3]); o.y = pk4_fp8(s[4], s[5], s[6], s[7]);
            *(GAS v2u*)((unsigned char*)dstv + (size_t)(n0 + n) * ldd + koff + k0 + 8 * cc) = o; }
        else { v4u o; o.x = pk2(s[0], s[1]); o.y = pk2(s[2], s[3]); o.z = pk2(s[4], s[5]); o.w = pk2(s[6], s[7]);
            *(GAS v4u*)((bf16*)dstv + (size_t)(n0 + n) * ldd + koff + k0 + 8 * cc) = o; } }
    LDS_WAIT(); asm volatile("" ::: "memory");
}
struct MapWin { const float* g; __device__ int col(int n) const { if (n < 384) return n; if (n < 416) return 384 + rope_dim(n - 384); if (n < 512) return -1; if (n < 2048) return n - 96; return 1952 + ((n >> 7) & 1) * 1024 + ((n - 2048) >> 8) * 128 + (n & 127); }        __device__ float scale(int k) const { return g[k]; } };
struct MapWin8 { const float* g; __device__ int col(int n) const { return 1952 + ((n >> 7) & 1) * 1024 + ((n - 2048) >> 8) * 128 + (n & 127); } __device__ float scale(int k) const { return g[k] * W8_SCALE; } };
struct MapWq { const float* g; __device__ int col(int n) const { if (n < 512) return (n >> 6) * 96 + (n & 63); const int h = (n - 512) >> 5; return h * 96 + 64 + rope_dim((n - 512) & 31); } __device__ float scale(int k) const { return g[k]; } };
struct MapWkv { const float* g; __device__ int col(int n) const { if (n < 512) return (n >> 6) * 128 + (n & 63); return ((n - 512) >> 6) * 128 + 64 + (n & 63); } __device__ float scale(int k) const { return g[k]; } };
struct MapId { __device__ int col(int n) const { return n; } __device__ float scale(int) const { return 1.f; } };
struct MapW2 { __device__ int col(int n) const { return n; } __device__ float scale(int) const { return W8_SCALE; } };
struct MapUpDiff { const float* g; __device__ int col(int n) const { return n; } __device__ float scale(int k) const { return 0.8f * g[k & 127]; } };
struct MapW1 { const float* g; __device__ int col(int n) const { return ((n >> 7) & 1) * 1024 + (n >> 8) * 128 + (n & 127); } __device__ float scale(int k) const { return g[k] * W8_SCALE; } };

__device__ __forceinline__ void rope_cs(int pos, int j, float& c, float& s) {
    const float freq = exp2f(-(float)j * (13.287712379549449f / 16.0f));
    const float angf = (float)pos * freq;
    const double a = (double)angf;
    const double TWO_PI = 6.283185307179586476925286766559;
    const double r = a - TWO_PI * rint(a / TWO_PI);
    const float rf = (float)r;
    c = __cosf(rf); s = __sinf(rf);
}

__device__ __forceinline__ void p0_prologue(const Args& a, LAS unsigned char* lds, int vcu, int G) {
    int tid = threadIdx.x; asm volatile("" : "+v"(tid)); const int lane = tid & 63, wave = __builtin_amdgcn_readfirstlane(tid >> 6);
    unsigned char* ws = a.ws;
    LAS float* scr = (LAS float*)(lds + RING_OFF + wave * 16640);
    const int gw = vcu * NWAVES + wave, NGW = G * NWAVES;
    { constexpr int I_IN = 64 * 16, I_Q = 12 * 4, I_KV = 16 * 4, I_UA = 16 * 8, I_UB = 16 * 8, I_O = 16 * 16, TOT = I_IN + I_Q + I_KV + I_UA + I_UB + I_O;
      const MapWin mwin{a.norm_mix}; const MapWin8 mwin8{a.norm_mix}; const MapWq mwq{a.mla_q_norm}; const MapWkv mwkv{a.mla_kv_norm}; const MapId mi{}; const MapUpDiff mud{a.diff_subln};
      for (int it = gw; it < TOT; it += NGW) {
          int r = it;
          if (r < I_IN) { if ((r >> 4) < 32) tr_item<false>(a.w_in, INT_TOTAL, 1024, (bf16*)(ws + WS_WIN), 1024, 0, mwin, scr, r & 15, r >> 4, lane);
                          else tr_item<true>(a.w_in, INT_TOTAL, 1024, ws + WS_WING8 - (size_t)2048 * 1024, 1024, 0, mwin8, scr, r & 15, r >> 4, lane);
                          continue; } r -= I_IN;
          if (r < I_Q) { tr_item<false>(a.w_q_b, 768, 256, (bf16*)(ws + WS_WQ), 256, 0, mwq, scr, r & 3, r >> 2, lane); continue; } r -= I_Q;
          if (r < I_KV) { tr_item<false>(a.w_kv_b, 1024, 128, (bf16*)(ws + WS_WKV), 256, 0, mwkv, scr, r & 3, r >> 2, lane); continue; } r -= I_KV;
          if (r < I_UA) { tr_item<false>(a.w_up_mla, 1024, 512, (bf16*)(ws + WS_WUP), 1024, 0, mi, scr, r & 7, r >> 3, lane); continue; } r -= I_UA;
          if (r < I_UB) { tr_item<false>(a.w_up_diff, 1024, 512, (bf16*)(ws + WS_WUP), 1024, 512, mud, scr, r & 7, r >> 3, lane); continue; } r -= I_UB;
          tr_item<false>(a.w_out, 1024, 1024, (bf16*)(ws + WS_WOUT), 1024, 0, mi, scr, r & 15, r >> 4, lane);
      } }
    { bf16* XB = (bf16*)(ws + WS_XB); float* RX = (float*)(ws + WS_RX);
      constexpr int XR = 4;
      for (int m0 = gw; m0 < NTOK; m0 += XR * NGW) {
          f32x4 v[XR][4];
#pragma unroll
          for (int q = 0; q < XR; ++q) { const int m = m0 + q * NGW; const GAS f32x4* xr = (const GAS f32x4*)(a.x + (size_t)(m < NTOK ? m : m0) * DM) + lane;
#pragma unroll
              for (int j = 0; j < 4; ++j) v[q][j] = xr[64 * j]; }
#pragma unroll
          for (int q = 0; q < XR; ++q) { const int m = m0 + q * NGW; float s = 0.f;
#pragma unroll
              for (int j = 0; j < 4; ++j) s += (v[q][j].x * v[q][j].x + v[q][j].y * v[q][j].y) + (v[q][j].z * v[q][j].z + v[q][j].w * v[q][j].w);
              s = wave_sum(s);
              if (m < NTOK) { if (lane == 0) RX[m] = rsqrtf(s * (1.f / DM) + EPS);
                  GAS unsigned long long* o8 = (GAS unsigned long long*)(XB + (size_t)m * DM) + lane;
#pragma unroll
                  for (int j = 0; j < 4; ++j) o8[64 * j] = (unsigned long long)pk2(v[q][j].x, v[q][j].y) | ((unsigned long long)pk2(v[q][j].z, v[q][j].w) << 32);
                  GAS unsigned* o4 = (GAS unsigned*)(ws + WS_XB8 + (size_t)m * DM) + lane;
#pragma unroll
                  for (int j = 0; j < 4; ++j) o4[64 * j] = pk4_fp8(v[q][j].x * X8_SCALE, v[q][j].y * X8_SCALE, v[q][j].z * X8_SCALE, v[q][j].w * X8_SCALE); } }
      } }
    { f32x2* CS = (f32x2*)(ws + WS_CS); float* WR = (float*)(ws + WS_WR);
      const int gt = vcu * NWAVES * 64 + tid, NGT = G * NWAVES * 64;
      for (int i = gt; i < NTOK * 16; i += NGT) { float c, s; rope_cs(a.pos[i >> 4], i & 15, c, s); CS[i] = (f32x2){c, s}; }
      for (int i = gt; i < DM * NE; i += NGT) { const int e = i >> 10, k = i & 1023; WR[i] = a.w_router[k * NE + e] * a.norm_ffn[k]; }
    }
}

using pg8::Unit; using pg8::HALF;
struct ProbPlain {
    const bf16* A; const bf16* Bt; int lda, ldb, acol, bcol, K;
    __device__ __forceinline__ const char* a_base() const { return (const char*)A; }
    __device__ __forceinline__ unsigned a_off(const Unit& u, int r) const { return (unsigned)(((u.pm * 256 + r) * lda + acol) * 2); }
    __device__ __forceinline__ const char* b_base(const Unit& u) const { return (const char*)(Bt + (size_t)u.pn * 256 * ldb + bcol); }
};
struct ProbPlain8 {
    static constexpr bool FP8 = true;
    const unsigned char* A; const unsigned char* Bt; int K, ldb;
    __device__ __forceinline__ const char* a_base() const { return (const char*)A; }
    __device__ __forceinline__ unsigned a_off(const Unit& u, int r) const { return (unsigned)(u.pm * 256 + r) * 1024u; }
    __device__ __forceinline__ const char* b_base(const Unit& u) const { return (const char*)(Bt + (size_t)u.pn * 256 * 1024); }
};
__device__ __forceinline__ float sigmoidf_(float v) { return __builtin_amdgcn_rcpf(1.f + __builtin_amdgcn_exp2f(-LOG2E * v)); }
__device__ __forceinline__ v4u pack8(const f32x4& v0, const f32x4& v1) { v4u w; w.x = pg8::cvt_pk_bf16(v0[0], v0[1]); w.y = pg8::cvt_pk_bf16(v0[2], v0[3]); w.z = pg8::cvt_pk_bf16(v1[0], v1[1]); w.w = pg8::cvt_pk_bf16(v1[2], v1[3]); return w; }
__device__ __forceinline__ float dot4(const f32x4& v) { return (v[0] * v[0] + v[1] * v[1]) + (v[2] * v[2] + v[3] * v[3]); }

struct EpiInProj {
    bf16* PROJ; bf16* KR; const float* RX; const f32x2* CS; float* SSQ_Q; float* SSQ_KV; LAS float* tl; int pn0; float asc;
    static constexpr bool HAS_PRE = true;
    __device__ __forceinline__ void pre(const Unit& u, int wid, int lane) const {
        if (wid == 7) __builtin_amdgcn_global_load_lds((const unsigned*)(RX + u.pm * 256 + lane * 4), (LAS unsigned*)(tl + (u.ord & 1) * 256), 16, 0, 0); }
    __device__ __forceinline__ void operator()(const f32x4 (&acc)[2][2][4][2], const Unit& u, int wr, int wc, int fr, int fq) const {
        const int pn = u.pn + pn0; const float sc = ((pn == 2 || pn == 3) ? C2D : 1.f) * asc;
#pragma unroll
        for (int ai = 0; ai < 2; ++ai)
#pragma unroll
            for (int m = 0; m < 4; ++m) {
                const int row = u.pm * 256 + ai * HALF + wr * 64 + m * 16 + fr;
                const float rx = tl[(u.ord & 1) * 256 + ai * HALF + wr * 64 + m * 16 + fr] * sc; float ssq = 0.f;
                f32x4 v[2][2];
#pragma unroll
                for (int bj = 0; bj < 2; ++bj) { v[bj][0] = acc[ai][bj][m][0] * rx; v[bj][1] = acc[ai][bj][m][1] * rx; }
                if (pn >= 8) {
#pragma unroll
                    for (int n = 0; n < 2; ++n)
#pragma unroll
                        for (int i = 0; i < 4; ++i) { const float em1 = 1.f + __builtin_amdgcn_exp2f(-LOG2E * v[0][n][i]), ed1 = 1.f + __builtin_amdgcn_exp2f(-LOG2E * v[1][n][i]);
                            v[1][n][i] = __builtin_amdgcn_rcpf(ed1); v[0][n][i] = ed1 * __builtin_amdgcn_rcpf(em1); } }
                if (pn == 0) ssq += (dot4(v[0][0]) + dot4(v[0][1])) + (dot4(v[1][0]) + dot4(v[1][1]));
                if (pn == 1) ssq += dot4(v[0][0]) + dot4(v[0][1]);
                if (pn == 1 && wc == 0) {
                    const f32x4 cs0 = *(const f32x4*)(CS + (size_t)row * 16 + 4 * fq), cs1 = *(const f32x4*)(CS + (size_t)row * 16 + 4 * fq + 2);
                    const float c[4] = {cs0[0], cs0[2], cs1[0], cs1[2]}, s[4] = {cs0[1], cs0[3], cs1[1], cs1[3]};
                    f32x4 o1, o2;
#pragma unroll
                    for (int i = 0; i < 4; ++i) { o1[i] = v[1][0][i] * c[i] - v[1][1][i] * s[i]; o2[i] = v[1][0][i] * s[i] + v[1][1][i] * c[i]; }
                    *(v4u*)(KR + (size_t)row * 32 + 8 * fq) = pack8(o1, o2);
                }
#pragma unroll
                for (int bj = 0; bj < 2; ++bj) *(v4u*)(PROJ + (size_t)row * NPROJ + pn * 256 + bj * HALF + wc * 32 + 8 * fq) = pack8(v[bj][0], v[bj][1]);
                if (pn <= 1) { ssq += __shfl_xor(ssq, 16); ssq += __shfl_xor(ssq, 32); if (fq == 0) *(float*)((char*)SSQ_Q + (size_t)pn * (WS_SSQKV - WS_SSQQ) + ((size_t)row * 4 + wc) * 4) = ssq; }
            }
    }
};

struct ProbQKV {
    const bf16* PROJ; const bf16* WQ; const bf16* WKV; int K, ldb;
    __device__ __forceinline__ const char* a_base() const { return (const char*)PROJ; }
    __device__ __forceinline__ unsigned a_off(const Unit& u, int r) const { return (unsigned)(((u.pm * 256 + r) * NPROJ + (u.e ? 256 : 0)) * 2); }
    __device__ __forceinline__ const char* b_base(const Unit& u) const { return (const char*)WQ + (size_t)u.e * (WS_WKV - WS_WQ) + (size_t)u.pn * (256 * 256 * 2); }
};
struct OrderQKV { int G, c;
    __device__ __forceinline__ bool next(int i, Unit& u) const { const int L = i * G + c; if (L >= 448) return false;
        if (L < 192) { u.e = 0; u.pm = L / 3; u.pn = L % 3; } else { const int l2 = L - 192; u.e = 1; u.pm = l2 >> 2; u.pn = l2 & 3; } u.rt = 0; u.ord = i; return true; } };
struct OrderIn16 { int G, c;
    __device__ __forceinline__ static int cnt(int v) { return v < 64 ? 2 : v < 128 ? 1 : (v < 192 ? 4 : 1); }
    __device__ __forceinline__ static void unit(int v, int i, Unit& u) {
        if (v < 128 && i == 0) { u.pm = v & 63; u.pn = v >> 6; return; }
        const int t = v < 64 ? v : v < 192 ? 64 + 4 * (v - 128) + i : 320 + (v - 192); u.pm = t / 6; u.pn = 2 + t % 6; }
    __device__ __forceinline__ bool next(int i, Unit& u) const { u.e = 0; u.rt = 0; u.ord = i;
        for (int v = c; v < 256; v += G) { const int n = cnt(v); if (i < n) { unit(v, i, u); return true; } i -= n; } return false; } };
struct OrderIn8 { int G, c;
    __device__ __forceinline__ static int cnt(int v) { return v < 64 ? 1 : v < 128 ? 2 : v < 192 ? 0 : 5; }
    __device__ __forceinline__ static int first(int v) { return v < 64 ? v : v < 128 ? 64 + 2 * (v - 64) : 192 + 5 * (v - 192); }
    __device__ __forceinline__ bool next(int i, Unit& u) const { u.e = 0; u.rt = 0; u.ord = i;
        for (int v = c; v < 256; v += G) { const int n = cnt(v); if (i < n) { const int s = first(v) + i; u.pm = s >> 3; u.pn = s & 7; return true; } i -= n; } return false; } };
struct OrderQKV2 { int G, c;
    __device__ __forceinline__ bool next(int i, Unit& u) const { u.rt = 0; u.ord = i;
        for (int v = c; v < 128; v += G) { const int n = v < 64 ? 3 : 4; if (i < n) { u.e = v >> 6; u.pm = v & 63; u.pn = i; return true; } i -= n; } return false; } };
struct EpiQKV {
    bf16* QM; bf16* KN; bf16* VM; const float* SSQ_Q; const float* SSQ_KV; const f32x2* CS;
    __device__ __forceinline__ void operator()(const f32x4 (&acc)[2][2][4][2], const Unit& u, int wr, int wc, int fr, int fq) const {
        const int pn = u.pn;
#pragma unroll
        for (int ai = 0; ai < 2; ++ai)
#pragma unroll
            for (int m = 0; m < 4; ++m) {
                const int row = u.pm * 256 + ai * HALF + wr * 64 + m * 16 + fr;
                const f32x4 pp = *(const f32x4*)((const char*)SSQ_Q + (size_t)u.e * (WS_SSQKV - WS_SSQQ) + (size_t)row * 16);
                const float ss = (pp[0] + pp[1]) + (pp[2] + pp[3]);
                const float rs = u.e ? rsqrtf(ss * (1.f / 128.f) + EPS) : rsqrtf(ss * (1.f / 256.f) + EPS) * C2M;
#pragma unroll
                for (int bj = 0; bj < 2; ++bj) {
                    f32x4 v0 = acc[ai][bj][m][0] * rs, v1 = acc[ai][bj][m][1] * rs;
                    const int n = pn * 256 + bj * HALF + wc * 32 + 8 * fq;
                    if (u.e == 0) {
                        if (pn < 2) { *(v4u*)(QM + (size_t)row * 768 + (n >> 6) * 96 + (n & 63)) = pack8(v0, v1); }
                        else { const int h = 4 * bj + wc;
                            const f32x4 cs0 = *(const f32x4*)(CS + (size_t)row * 16 + 4 * fq), cs1 = *(const f32x4*)(CS + (size_t)row * 16 + 4 * fq + 2);
                            const float c[4] = {cs0[0], cs0[2], cs1[0], cs1[2]}, s[4] = {cs0[1], cs0[3], cs1[1], cs1[3]};
                            f32x4 o1, o2;
#pragma unroll
                            for (int i = 0; i < 4; ++i) { o1[i] = v0[i] * c[i] - v1[i] * s[i]; o2[i] = v0[i] * s[i] + v1[i] * c[i]; }
                            *(v4u*)(QM + (size_t)row * 768 + h * 96 + 64 + 8 * fq) = pack8(o1, o2); }
                    } else {
                        if (pn < 2) *(v4u*)(KN + (size_t)row * 512 + n) = pack8(v0, v1);
                        else *(v4u*)(VM + (size_t)row * 512 + (n - 512)) = pack8(v0, v1);
                    }
                }
            }
    }
};

__device__ __forceinline__ void unpack8(const v4u& g, float (&f)[8]) { f[0] = bf2f(g.x & 0xffffu); f[1] = bf2f(g.x >> 16); f[2] = bf2f(g.y & 0xffffu); f[3] = bf2f(g.y >> 16); f[4] = bf2f(g.z & 0xffffu); f[5] = bf2f(g.z >> 16); f[6] = bf2f(g.w & 0xffffu); f[7] = bf2f(g.w >> 16); }
struct EpiUp { bf16* MG; const bf16* PROJ;
    static constexpr bool HAS_MID = true;
    __device__ __forceinline__ void mid(f32x4 (&acc)[2][2][4][2], const Unit& u, int wr, int wc, int fr, int fq) const {
        int row0 = u.pm * 256 + wr * 64 + fr; asm volatile("" : "+v"(row0));
#pragma unroll
        for (int ai = 0; ai < 2; ++ai)
#pragma unroll
            for (int m = 0; m < 4; ++m) { const int row = row0 + ai * HALF + m * 16;
#pragma unroll
                for (int bj = 0; bj < 2; ++bj) { const int c = (u.pn * 2 + bj) * 256 + wc * 32 + 8 * fq;
                    const v4u ga = *(const v4u*)(PROJ + (size_t)row * NPROJ + 2048 + c);
                    float fa[8]; unpack8(ga, fa);
#pragma unroll
                    for (int i = 0; i < 4; ++i) { acc[ai][bj][m][0][i] *= fa[i]; acc[ai][bj][m][1][i] *= fa[4 + i]; } }
                asm volatile("" : "+v"(acc[ai][0][m][0]), "+v"(acc[ai][0][m][1]), "+v"(acc[ai][1][m][0]), "+v"(acc[ai][1][m][1]) :: "memory"); }
    }
    __device__ __forceinline__ void operator()(const f32x4 (&acc)[2][2][4][2], const Unit& u, int wr, int wc, int fr, int fq) const {
#pragma unroll
        for (int ai = 0; ai < 2; ++ai)
#pragma unroll
            for (int m = 0; m < 4; ++m) { const int row = u.pm * 256 + ai * HALF + wr * 64 + m * 16 + fr;
#pragma unroll
                for (int bj = 0; bj < 2; ++bj) { const int c = u.pn * 256 + bj * HALF + wc * 32 + 8 * fq;
                    const v4u gb = *(const v4u*)(PROJ + (size_t)row * NPROJ + 2048 + 128 + (u.pn * 2 + bj) * 256 + wc * 32 + 8 * fq); float fb[8]; unpack8(gb, fb);
                    f32x4 v0 = acc[ai][bj][m][0], v1 = acc[ai][bj][m][1];
#pragma unroll
                    for (int i = 0; i < 4; ++i) { v0[i] *= fb[i]; v1[i] *= fb[4 + i]; }
                    *(v4u*)(MG + (size_t)row * DM + c) = pack8(v0, v1); } }
    }
};
struct EpiOut { const float* X; bf16* X1; float* SSQ2;
    __device__ __forceinline__ void operator()(const f32x4 (&acc)[2][2][4][2], const Unit& u, int wr, int wc, int fr, int fq) const {
#pragma unroll
        for (int ai = 0; ai < 2; ++ai)
#pragma unroll
            for (int m = 0; m < 4; ++m) { const int row = u.pm * 256 + ai * HALF + wr * 64 + m * 16 + fr; float ssq = 0.f;
#pragma unroll
                for (int bj = 0; bj < 2; ++bj) { const int c = u.pn * 256 + bj * HALF + wc * 32 + 8 * fq;
                    const f32x4 x0 = *(const f32x4*)(X + (size_t)row * DM + c), x1 = *(const f32x4*)(X + (size_t)row * DM + c + 4);
                    const f32x4 v0 = acc[ai][bj][m][0] + x0, v1 = acc[ai][bj][m][1] + x1;
                    ssq += dot4(v0) + dot4(v1);
                    *(v4u*)(X1 + (size_t)row * DM + c) = pack8(v0, v1); }
                ssq += __shfl_xor(ssq, 16); ssq += __shfl_xor(ssq, 32); if (fq == 0) SSQ2[(size_t)row * 16 + u.pn * 4 + wc] = ssq; }
    }
};

struct ExpertTab { LAS int* tab; };
struct OrderExpert { LAS const int* tab; int nN, G, c, base, win;
    __device__ __forceinline__ bool next(int i, Unit& u) const {
        if (i >= win) return false;
        const int x = c & 7; int idx = (base + i) * (G >> 3) + (c >> 3);
#pragma unroll
        for (int j = 0; j < 4; ++j) { const int e = x + 8 * j; const int nt = tab[33 + e] - tab[32 + e]; const int n = nt * nN;
            if (idx < n) { u.e = e; u.rt = idx / nN; u.pn = idx % nN; u.pm = tab[32 + e] + u.rt; u.ord = i; return true; } idx -= n; }
        return false; } };
constexpr int TOKT_OFF = RING_BYTES, TOKT_UNITS = 16;
template <bool LDSTOK> struct ProbExp1 {
    static constexpr bool FP8 = true;
    const unsigned char* XQ; const unsigned char* W1T8; const int* TOKL; LAS const int* tab; LAS const unsigned short* tokT; int K, ldb;
    __device__ __forceinline__ const char* a_base() const { return (const char*)XQ; }
    __device__ __forceinline__ int tok_g(const Unit& u, int r) const { const int slot = u.rt * 256 + r, last = tab[u.e] - 1; return TOKL[u.e * NTOK + (slot < last ? slot : last)]; }
    __device__ __forceinline__ int tok(const Unit& u, int r) const { if constexpr (LDSTOK) return (int)tokT[u.ord * 256 + r]; else return tok_g(u, r); }
    __device__ __forceinline__ unsigned a_off(const Unit& u, int r) const { return (unsigned)tok(u, r) * 1024u; }
    __device__ __forceinline__ const char* b_base(const Unit& u) const { return (const char*)(W1T8 + ((size_t)u.e * 2048 + (size_t)u.pn * 256) * 1024); }
};
__device__ __forceinline__ v4u pair16(const v2u& wa, const v2u& wb) {
    const auto r0 = __builtin_amdgcn_permlane16_swap(wa.x, wb.x, false, false), r1 = __builtin_amdgcn_permlane16_swap(wa.y, wb.y, false, false);
    return (v4u){r0[0], r1[0], r0[1], r1[1]};
}
struct EpiExp1 { unsigned char* HB; const float* B1; LAS float* tl;
    static constexpr bool HAS_PRE = true;
    __device__ __forceinline__ void pre(const Unit& u, int wid, int lane) const {
        if (wid == 7) __builtin_amdgcn_global_load_lds((const unsigned*)(B1 + (size_t)u.e * 2048 + (lane >> 5) * 1024 + u.pn * 128 + (lane & 31) * 4), (LAS unsigned*)(tl + (u.ord & 1) * 256), 16, 0, 0); }
    __device__ __forceinline__ void operator()(const f32x4 (&acc)[2][2][4][2], const Unit& u, int wr, int wc, int fr, int fq) const {
        const int j0 = u.pn * 128 + wc * 32 + 8 * fq;
        LAS const float* bt = tl + (u.ord & 1) * 256 + wc * 32 + 8 * fq;
        const f32x4 bg0 = *(LAS const f32x4*)bt, bg1 = *(LAS const f32x4*)(bt + 4), bl0 = *(LAS const f32x4*)(bt + 128), bl1 = *(LAS const f32x4*)(bt + 132);
        constexpr float RS = 1.0f / W8_SCALE;
#pragma unroll
        for (int ai = 0; ai < 2; ++ai)
#pragma unroll
            for (int mp = 0; mp < 4; mp += 2) { v2u w[2];
#pragma unroll
                for (int mm = 0; mm < 2; ++mm) { const int m = mp + mm;
                    const f32x4 g0 = acc[ai][0][m][0] * RS + bg0, g1 = acc[ai][0][m][1] * RS + bg1, l0 = acc[ai][1][m][0] * RS + bl0, l1 = acc[ai][1][m][1] * RS + bl1;
                    f32x4 o0, o1;
#pragma unroll
                    for (int i = 0; i < 4; ++i) {
                        { const float g = fminf(g0[i], 7.f), l = fminf(fmaxf(l0[i], -7.f), 7.f); o0[i] = g * __builtin_amdgcn_rcpf(1.f + __builtin_amdgcn_exp2f(-1.702f * LOG2E * g)) * __builtin_fmaf(l, H8_SCALE, H8_SCALE); }
                        { const float g = fminf(g1[i], 7.f), l = fminf(fmaxf(l1[i], -7.f), 7.f); o1[i] = g * __builtin_amdgcn_rcpf(1.f + __builtin_amdgcn_exp2f(-1.702f * LOG2E * g)) * __builtin_fmaf(l, H8_SCALE, H8_SCALE); } }
                    w[mm].x = pk4_fp8(o0[0], o0[1], o0[2], o0[3]); w[mm].y = pk4_fp8(o1[0], o1[1], o1[2], o1[3]); }
                const int r = ai * HALF + wr * 64 + (mp + (fq & 1)) * 16 + fr;
                *(v4u*)(HB + (size_t)(u.pm * 256 + r) * 1024 + j0 - 8 * (fq & 1)) = pair16(w[0], w[1]); }
    }
};
struct ProbExp2 { static constexpr bool FP8 = true; const unsigned char* HB; const unsigned char* W2T8; int K, ldb;
    __device__ __forceinline__ const char* a_base() const { return (const char*)HB; }
    __device__ __forceinline__ unsigned a_off(const Unit& u, int r) const { return (unsigned)(u.pm * 256 + r) * 1024u; }
    __device__ __forceinline__ const char* b_base(const Unit& u) const { return (const char*)(W2T8 + ((size_t)u.e * 1024 + (size_t)u.pn * 256) * 1024); }
};
struct EpiExp2 { unsigned char* YB; const float* B2; LAS float* tl;
    static constexpr bool HAS_PRE = true;
    __device__ __forceinline__ void pre(const Unit& u, int wid, int lane) const {
        if (wid == 7) __builtin_amdgcn_global_load_lds((const unsigned*)(B2 + (size_t)u.e * 1024 + u.pn * 256 + lane * 4), (LAS unsigned*)(tl + (u.ord & 1) * 256), 16, 0, 0); }
    __device__ __forceinline__ void operator()(const f32x4 (&acc)[2][2][4][2], const Unit& u, int wr, int wc, int fr, int fq) const {
#pragma unroll
        for (int bj = 0; bj < 2; ++bj) { const int c = u.pn * 256 + bj * HALF + wc * 32 + 8 * fq;
            LAS const float* bt = tl + (u.ord & 1) * 256 + bj * HALF + wc * 32 + 8 * fq;
            const f32x4 b0 = *(LAS const f32x4*)bt * Y8_SCALE, b1 = *(LAS const f32x4*)(bt + 4) * Y8_SCALE;
#pragma unroll
            for (int ai = 0; ai < 2; ++ai)
#pragma unroll
                for (int mp = 0; mp < 4; mp += 2) { v2u w[2];
                    constexpr float RS = Y8_SCALE / (W8_SCALE * H8_SCALE);
#pragma unroll
                    for (int mm = 0; mm < 2; ++mm) { const f32x4 y0 = acc[ai][bj][mp + mm][0] * RS + b0, y1 = acc[ai][bj][mp + mm][1] * RS + b1;
                        w[mm].x = pk4_fp8(y0[0], y0[1], y0[2], y0[3]); w[mm].y = pk4_fp8(y1[0], y1[1], y1[2], y1[3]); }
                    const int r = ai * HALF + wr * 64 + (mp + (fq & 1)) * 16 + fr;
                    *(v4u*)(YB + (size_t)(u.pm * 256 + r) * 1024 + c - 8 * (fq & 1)) = pair16(w[0], w[1]); } }
    }
};
__device__ __forceinline__ void build_expert_tab(const gu32* ctl, LAS int* tab, int tid) {
    if (tid < NE) tab[tid] = (int)ctl[CW_GCNT + tid];
    LDS_WAIT(); __syncthreads();
    if (tid == 0) { int p = 0; for (int e = 0; e < NE; ++e) { tab[32 + e] = p; p += (tab[e] + 255) >> 8; } tab[64] = p; }
    LDS_WAIT(); __syncthreads();
}

namespace att {
using bf16x8 = __attribute__((ext_vector_type(8))) short;
using s16x4 = __attribute__((ext_vector_type(4))) short;
using f32x16 = __attribute__((ext_vector_type(16))) float;
typedef short v4i16_t __attribute__((ext_vector_type(4)));
typedef LAS const char* lds_cptr;
__constant__ unsigned char T5_BUCKET[128] = {0, 1, 2, 3, 4, 5, 6, 7, 8, 9, 10, 11, 12, 13, 14, 15, 16, 16, 16, 17, 17, 18, 18, 18, 19, 19, 19, 20, 20, 20, 20, 21, 21, 21, 21, 22, 22, 22, 22, 22, 23, 23, 23, 23, 23, 23, 24, 24, 24, 24, 24, 24, 25, 25, 25, 25, 25, 25, 25, 26, 26, 26, 26, 26, 26, 26, 26, 27, 27, 27, 27, 27, 27, 27, 27, 27, 27, 28, 28, 28, 28, 28, 28, 28, 28, 28, 28, 29, 29, 29, 29, 29, 29, 29, 29, 29, 29, 29, 29, 30, 30, 30, 30, 30, 30, 30, 30, 30, 30, 30, 30, 30, 30, 31, 31, 31, 31, 31, 31, 31, 31, 31, 31, 31, 31, 31, 31, 31};
constexpr int NS = 5;
constexpr int WSF_OFF = NS * 24576, BIAS_OFF = WSF_OFF + 8 * 256, ATT_LDS = BIAS_OFF + 512;
static_assert(ATT_LDS <= RING_BYTES, "attention LDS");
#define ASBAR() __builtin_amdgcn_sched_barrier(0)
#define AMFMA(a, b, c) __builtin_amdgcn_mfma_f32_32x32x16_bf16(a, b, c, 0, 0, 0)
#define ABAR_L() asm volatile("s_waitcnt lgkmcnt(0)\n\ts_barrier" ::: "memory")
#define ABAR_VL() asm volatile("s_waitcnt vmcnt(0) lgkmcnt(0)\n\ts_barrier" ::: "memory")
__device__ __forceinline__ int crow(int r, int hi) { return (r & 3) + 8 * (r >> 2) + 4 * hi; }
__device__ __forceinline__ void glds16(const void* gsrc, unsigned lds_dst) { unsigned keep;
    asm volatile("s_mov_b32 %0, m0\n\ts_mov_b32 m0, %2\n\ts_nop 0\n\tglobal_load_lds_dwordx4 %1, off\n\ts_mov_b32 m0, %0" : "=&s"(keep) : "v"(gsrc), "s"(lds_dst) : "memory"); }
__device__ __forceinline__ void glds16_s(const char* sbase, unsigned voff, unsigned lds_dst) { unsigned keep;
    asm volatile("s_mov_b32 %0, m0\n\ts_mov_b32 m0, %3\n\ts_nop 0\n\tglobal_load_lds_dwordx4 %1, %2\n\ts_mov_b32 m0, %0" : "=&s"(keep) : "v"(voff), "s"(sbase), "s"(lds_dst) : "memory"); }
__device__ __forceinline__ float max3f(float a, float b, float c) { return __builtin_fmaxf(__builtin_fmaxf(a, b), c); }
__device__ __forceinline__ s16x4 vtr(lds_cptr p) { return __builtin_bit_cast(s16x4, __builtin_amdgcn_ds_read_tr16_b64_v4i16((LAS v4i16_t*)p)); }
typedef float f32x2_t __attribute__((ext_vector_type(2))); typedef __bf16 bf16x2_t __attribute__((ext_vector_type(2)));
__device__ __forceinline__ unsigned cvtpk_s(float lo, float hi) { f32x2_t v = {lo, hi}; bf16x2_t b = __builtin_convertvector(v, bf16x2_t); return __builtin_bit_cast(unsigned, b); }

struct ConvArgs { const float* w1; const float* w2; const float* nf; unsigned char* W1T8; unsigned char* W2T8; int stride; int mode; };
struct ConvState { int next, ne, nr, ce, cr, pending; };
constexpr int CONV_PER_E = 3072, CONV_NITEM = 32 * CONV_PER_E;
__device__ __forceinline__ void conv_issue(const ConvArgs& C, int e, int r, unsigned stage, int lane) {
    const bool is1 = r < 2048; const int r2 = is1 ? r : r - 2048, kb = r2 & 63, nb = r2 >> 6;
    const int pitch = is1 ? 2048 : 1024;
    const int col0 = is1 ? (((nb >> 1) & 1) * 1024 + (nb >> 2) * 128 + (nb & 1) * 64) : 64 * nb;
    const float* src = (is1 ? C.w1 + (size_t)e * 1024 * 2048 : C.w2 + (size_t)e * 1024 * 1024) + (size_t)(16 * kb + (lane >> 4)) * pitch + col0 + 4 * (lane & 15);
#pragma unroll
    for (int q = 0; q < 4; ++q) glds16(src + (size_t)(4 * q) * pitch, (unsigned)__builtin_amdgcn_readfirstlane(stage + q * 1024));
}
__device__ __forceinline__ void conv_finish(const ConvArgs& C, int e, int r, LAS const float* stg, int lane) {
    const bool is1 = r < 2048; const int r2 = is1 ? r : r - 2048, kb = r2 & 63, nb = r2 >> 6, k0 = 16 * kb;
    float v[16];
#ifdef PROBE_ATT_MODE
    if (C.mode == 4) return;
    if (C.mode == 6) {
#pragma unroll
        for (int k = 0; k < 16; ++k) v[k] = (float)(lane + k);
    } else
#endif
    {
#pragma unroll
    for (int k = 0; k < 16; ++k) v[k] = stg[k * 64 + lane];
    }
#ifdef PROBE_ATT_MODE
    if (C.mode == 5) { asm volatile("" :: "v"(v[0]), "v"(v[1]), "v"(v[2]), "v"(v[3]), "v"(v[4]), "v"(v[5]), "v"(v[6]), "v"(v[7]), "v"(v[8]), "v"(v[9]), "v"(v[10]), "v"(v[11]), "v"(v[12]), "v"(v[13]), "v"(v[14]), "v"(v[15])); return; }
#endif
    if (is1) {
        const __attribute__((address_space(4))) float* nfc = (const __attribute__((address_space(4))) float*)(uintptr_t)C.nf + __builtin_amdgcn_readfirstlane(k0);
#pragma unroll
        for (int k = 0; k < 16; ++k) v[k] *= nfc[k] * W8_SCALE;
    } else {
#pragma unroll
        for (int k = 0; k < 16; ++k) v[k] *= W8_SCALE;
    }
    v4u o; o.x = pk4_fp8(v[0], v[1], v[2], v[3]); o.y = pk4_fp8(v[4], v[5], v[6], v[7]); o.z = pk4_fp8(v[8], v[9], v[10], v[11]); o.w = pk4_fp8(v[12], v[13], v[14], v[15]);
    unsigned char* dst = (is1 ? C.W1T8 + ((size_t)e * 2048 + 64 * nb + lane) * 1024 : C.W2T8 + ((size_t)e * 1024 + 64 * nb + lane) * 1024) + k0;
    *(v4u*)dst = o;
}
struct AttnP {
    const bf16* Q; int qp; const bf16* K; int kp; const bf16* K2; int k2p; const bf16* V; int vp; bf16* O; int op;
    const float* rel_bias; int bh;
};

template <int DQK, int DV, bool BIAS>
__device__ __forceinline__ void attn_unit(const AttnP& T, int qb, LAS unsigned char* shm, const ConvArgs& CV, ConvState& cs) {
    constexpr int NKP = DQK / 8, NVP = DV / 8, NP = NKP + NVP, SLOTB = NP * 1024, KS = DQK / 16, DB = DV / 32, VOFF = NKP * 1024;
    static_assert(SLOTB <= 24576, "slot size");
    constexpr float THR = 8.0f;
    int tid = threadIdx.x; asm volatile("" : "+v"(tid));
    const int lane = tid & 63, r32 = lane & 31, hi = lane >> 5; const int wid = __builtin_amdgcn_readfirstlane(tid >> 6);
    const int half = wid >> 2;
    const int q0 = qb * 256, NT = (q0 + 256) / 64;
    const unsigned lds0 = (unsigned)(uintptr_t)shm;
    LAS float* wsf = (LAS float*)(shm + WSF_OFF) + wid * 64;
    LAS float* biasL = (LAS float*)(shm + BIAS_OFF);
    const char* dsb[3]; unsigned dvo[3]; int dstride[3];
#pragma unroll
    for (int pi_ = 0; pi_ < 3; ++pi_) { const int p_ = wid + 8 * pi_; dsb[pi_] = (const char*)T.K; dvo[pi_] = 0u; dstride[pi_] = 0;
        if (p_ < NKP) { if (DQK == 96 && p_ >= 8) { dsb[pi_] = (const char*)(T.K2 + (p_ - 8) * 8); dvo[pi_] = (unsigned)(lane * T.k2p) * 2u; dstride[pi_] = 128 * T.k2p; } else { dsb[pi_] = (const char*)(T.K + p_ * 8); dvo[pi_] = (unsigned)(lane * T.kp) * 2u; dstride[pi_] = 128 * T.kp; } }
        else if (p_ < NP) { const int pv_ = p_ - NKP; dsb[pi_] = (const char*)(T.V + (size_t)(16 * (pv_ & 3)) * T.vp + (pv_ >> 2) * 32); dvo[pi_] = (unsigned)((lane >> 2) * T.vp + (lane & 3) * 8) * 2u; dstride[pi_] = 128 * T.vp; }
        asm volatile("" : "+v"(dvo[pi_])); }
    const unsigned ddst0 = lds0 + wid * 1024;
#define DMA_NEXT(slotoff) do { _Pragma("unroll") for (int pi_ = 0; pi_ < 3; ++pi_) { if (pi_ < 2 || NP == 24 || wid < NP - 16) { \
        glds16_s(dsb[pi_], dvo[pi_], (unsigned)__builtin_amdgcn_readfirstlane(ddst0 + (slotoff) + pi_ * 8192)); dsb[pi_] += dstride[pi_]; } } } while (0)
    DMA_NEXT(0); DMA_NEXT(SLOTB); DMA_NEXT(2 * SLOTB);
    bf16x8 qr[KS];
    { const bf16* Qw = T.Q + (size_t)(q0 + wid * 32 + r32) * T.qp + hi * 8;
#pragma unroll
      for (int ks = 0; ks < KS; ++ks) qr[ks] = *reinterpret_cast<const bf16x8*>(Qw + ks * 16);
#pragma unroll
      for (int ks = 0; ks < KS; ++ks) asm volatile("" : "+v"(qr[ks])); }
    if (BIAS) { if (tid < 128) { const float b31 = T.rel_bias[31 * 4 + T.bh]; biasL[tid] = (T.rel_bias[(int)T5_BUCKET[tid] * 4 + T.bh] - b31) * LOG2E; } }
    float mhat = 0.f, l_reg = 0.f;
    f32x16 o[DB];
#pragma unroll
    for (int d = 0; d < DB; ++d) o[d] = f32x16{};
    f32x16 negm = f32x16{}; asm volatile("" : "+v"(negm));
    typedef unsigned u32x4 __attribute__((ext_vector_type(4)));
    u32x4 pw0 = {0u, 0u, 0u, 0u}, pw1 = pw0, pw2 = pw0, pw3 = pw0;
    const int qrel = wid * 32 + r32;
    const lds_cptr shm3 = (lds_cptr)shm;
    const lds_cptr kp0 = shm3 + hi * 1024 + r32 * 16;
    const lds_cptr vp0 = shm3 + VOFF + ((lane >> 4) & 1) * 32 + (lane & 3) * 8 + (4 * hi + ((lane & 15) >> 2)) * 64;
    ABAR_VL();
    bf16x8 kf[2 * KS];
#define KLOAD(slotoff) do { const lds_cptr kb_ = kp0 + (slotoff); _Pragma("unroll") for (int ks = 0; ks < KS; ++ks) { kf[2 * ks] = *(const LAS bf16x8*)(kb_ + ks * 2048); kf[2 * ks + 1] = *(const LAS bf16x8*)(kb_ + ks * 2048 + 512); } } while (0)
    KLOAD(0);
    if (half == 1) ABAR_L();
    s16x4 vl[2][4], vh[2][4];
#define VRD(buf, d0, slotoff) do { const lds_cptr vp_ = vp0 + (slotoff) + (d0) * 4096; _Pragma("unroll") for (int ks = 0; ks < 4; ++ks) { vl[buf][ks] = vtr(vp_ + ks * 1024); vh[buf][ks] = vtr(vp_ + ks * 1024 + 512); } } while (0)
#define VFR(buf, k) ((bf16x8){vl[buf][k][0], vl[buf][k][1], vl[buf][k][2], vl[buf][k][3], vh[buf][k][0], vh[buf][k][1], vh[buf][k][2], vh[buf][k][3]})
#define PV_BLK(buf, d0) do { o[d0] = AMFMA(__builtin_bit_cast(bf16x8, pw0), VFR(buf, 0), o[d0]); o[d0] = AMFMA(__builtin_bit_cast(bf16x8, pw1), VFR(buf, 1), o[d0]); \
        o[d0] = AMFMA(__builtin_bit_cast(bf16x8, pw2), VFR(buf, 2), o[d0]); o[d0] = AMFMA(__builtin_bit_cast(bf16x8, pw3), VFR(buf, 3), o[d0]); } while (0)
#define SGB_MFMA_DS(nm, nd) do { __builtin_amdgcn_sched_group_barrier(0x8, nm, 0); __builtin_amdgcn_sched_group_barrier(0x100, nd, 0); } while (0)
#define PV_ALL(slotoff) do { _Pragma("unroll") for (int d0 = 0; d0 < DB; ++d0) { if (d0 + 1 < DB) VRD((d0 + 1) & 1, d0 + 1, slotoff); PV_BLK(d0 & 1, d0); \
        if (d0 + 1 < DB) { SGB_MFMA_DS(1, 2); SGB_MFMA_DS(1, 2); SGB_MFMA_DS(1, 2); SGB_MFMA_DS(1, 2); } ASBAR(); } } while (0)
    int sl_prev = 4 * SLOTB, slot_t = 0, sl_d = 3 * SLOTB;
    for (int t = 0; t < NT; ++t) {
        ASBAR();
        __builtin_amdgcn_s_setprio(1);
        const bool more = (t + 3 < NT);
        f32x16 s0, s1;
#define QK_ALL() do { _Pragma("unroll") for (int ks = 0; ks < KS; ++ks) { \
            if (ks == 0) { s0 = AMFMA(kf[0], qr[0], negm); s1 = AMFMA(kf[1], qr[0], negm); } \
            else { s0 = AMFMA(kf[2 * ks], qr[ks], s0); s1 = AMFMA(kf[2 * ks + 1], qr[ks], s1); } } } while (0)
        if (t > 0) {
            VRD(0, 0, sl_prev); QK_ALL();
            SGB_MFMA_DS(1, 1); SGB_MFMA_DS(1, 1); SGB_MFMA_DS(1, 1); SGB_MFMA_DS(1, 1); SGB_MFMA_DS(1, 1); SGB_MFMA_DS(1, 1); SGB_MFMA_DS(1, 1); SGB_MFMA_DS(1, 1);
            __builtin_amdgcn_sched_group_barrier(0x8, 2 * KS - 8, 0);
        } else { QK_ALL(); }
#undef QK_ALL
        ASBAR();
        if (more) DMA_NEXT(sl_d);
        ASBAR();
        if (t > 0) PV_ALL(sl_prev);
        __builtin_amdgcn_s_setprio(0);
#if defined(ATT_NOP_M)
        asm volatile("s_nop 15\n\ts_nop 15\n\ts_nop 15\n\ts_nop 15\n\ts_nop 15\n\ts_nop 15\n\ts_nop 15\n\ts_nop 15\n\ts_nop 15\n\ts_nop 15\n\ts_nop 15\n\ts_nop 15\n\ts_nop 15\n\ts_nop 15\n\ts_nop 15\n\ts_nop 15" ::: "memory");
#endif
        ASBAR();
        if (more) { if (NP == 24 || wid < (NP - 16)) asm volatile("s_waitcnt vmcnt(3) lgkmcnt(0)\n\ts_barrier" ::: "memory"); else asm volatile("s_waitcnt vmcnt(2) lgkmcnt(0)\n\ts_barrier" ::: "memory"); }
        else ABAR_VL();
        ASBAR();
        { const int jb = t - (NT - 4);
          if (jb >= 0) { const int kb_ = 64 * jb + 4 * hi;
#pragma unroll
              for (int r = 0; r < 16; ++r) { const int kv = kb_ + (r & 3) + 8 * (r >> 2); if (kv > qrel) s0[r] = -INFINITY; if (kv + 32 > qrel) s1[r] = -INFINITY; } }
          if (BIAS) { if (q0 + wid * 32 - (64 * t + 63) < 113) {
              const int db = q0 + qrel - 64 * t - 4 * hi;
#pragma unroll
              for (int r = 0; r < 16; ++r) { int d0_ = db - ((r & 3) + 8 * (r >> 2)); int d1_ = d0_ - 32;
                  d0_ = d0_ < 0 ? 0 : (d0_ > 127 ? 127 : d0_); d1_ = d1_ < 0 ? 0 : (d1_ > 127 ? 127 : d1_);
                  s0[r] += biasL[d0_]; s1[r] += biasL[d1_]; } } }
          float a_ = max3f(s0[0], s0[1], s1[0]), b_ = max3f(s0[2], s0[3], s1[1]); a_ = max3f(a_, s1[2], s1[3]);
#pragma unroll
          for (int r = 4; r < 16; r += 4) { a_ = max3f(a_, s0[r], s0[r + 1]); b_ = max3f(b_, s0[r + 2], s0[r + 3]); a_ = max3f(a_, s1[r], s1[r + 1]); b_ = max3f(b_, s1[r + 2], s1[r + 3]); }
          float rm = __builtin_fmaxf(a_, b_);
          { auto rr = __builtin_amdgcn_permlane32_swap(__float_as_uint(rm), __float_as_uint(rm), false, false); rm = __builtin_fmaxf(__uint_as_float(rr[0]), __uint_as_float(rr[1])); }
          if (t == 0 || __any(rm > THR)) {
              const float dl = (t == 0) ? rm : __builtin_fmaxf(rm, 0.f);
              mhat += dl;
#pragma unroll
              for (int r = 0; r < 16; ++r) { s0[r] -= dl; s1[r] -= dl; }
#pragma unroll
              for (int r = 0; r < 16; ++r) negm[r] = -mhat;
              asm volatile("" : "+v"(negm));
              if (t > 0) { const float f = __builtin_amdgcn_exp2f(-dl); l_reg *= f; if (hi == 0) wsf[r32] = f;
                  LDS_WAIT();
                  float fr_[16];
#pragma unroll
                  for (int r = 0; r < 16; ++r) fr_[r] = wsf[crow(r, hi)];
#pragma unroll
                  for (int d = 0; d < DB; ++d)
#pragma unroll
                      for (int r = 0; r < 16; ++r) o[d][r] *= fr_[r];
              }
          }
#if defined(ATT_DUP_V)
          { float sa_ = 0.f;
#pragma unroll
            for (int r = 0; r < 16; ++r) { float x_ = s0[r], y_ = s1[r]; asm volatile("" : "+v"(x_), "+v"(y_)); x_ = __builtin_amdgcn_exp2f(x_); y_ = __builtin_amdgcn_exp2f(y_); sa_ += x_ + y_; unsigned w_ = cvtpk_s(x_, y_); asm volatile("" :: "v"(w_)); }
            asm volatile("" :: "v"(sa_)); }
#endif
#pragma unroll
          for (int r = 0; r < 16; ++r) { s0[r] = __builtin_amdgcn_exp2f(s0[r]); s1[r] = __builtin_amdgcn_exp2f(s1[r]); }
          { float one_ = 1.0f; asm volatile("" : "+v"(one_)); float a0_ = 0.f, a1_ = 0.f;
#pragma unroll
            for (int r = 0; r < 16; ++r) { a0_ = a0_ + s0[r]; a1_ = __builtin_fmaf(s1[r], one_, a1_); }
            l_reg += a0_ + a1_; }
          pw0 = (u32x4){cvtpk_s(s0[0], s0[1]), cvtpk_s(s0[2], s0[3]), cvtpk_s(s0[4], s0[5]), cvtpk_s(s0[6], s0[7])};
          pw1 = (u32x4){cvtpk_s(s0[8], s0[9]), cvtpk_s(s0[10], s0[11]), cvtpk_s(s0[12], s0[13]), cvtpk_s(s0[14], s0[15])};
          pw2 = (u32x4){cvtpk_s(s1[0], s1[1]), cvtpk_s(s1[2], s1[3]), cvtpk_s(s1[4], s1[5]), cvtpk_s(s1[6], s1[7])};
          pw3 = (u32x4){cvtpk_s(s1[8], s1[9]), cvtpk_s(s1[10], s1[11]), cvtpk_s(s1[12], s1[13]), cvtpk_s(s1[14], s1[15])};
        }
        if (t + 1 < NT) KLOAD((slot_t == 4 * SLOTB) ? 0 : slot_t + SLOTB);
        if ((t & 3) == 0) {
            LAS const float* stg_ = (LAS const float*)(shm + CONV_OFF + wid * 4096);
            if (cs.pending) { conv_finish(CV, cs.ce, cs.cr, stg_, lane); cs.pending = 0; }
            if (cs.next < CONV_NITEM) { LDS_WAIT(); conv_issue(CV, cs.ne, cs.nr, lds0 + CONV_OFF + wid * 4096, lane); cs.ce = cs.ne; cs.cr = cs.nr; cs.pending = 1;
                cs.next += CV.stride; cs.nr += CV.stride; while (cs.nr >= CONV_PER_E) { cs.nr -= CONV_PER_E; ++cs.ne; } }
        }
#if defined(ATT_NOP_V)
        asm volatile("s_nop 15\n\ts_nop 15\n\ts_nop 15\n\ts_nop 15\n\ts_nop 15\n\ts_nop 15\n\ts_nop 15\n\ts_nop 15\n\ts_nop 15\n\ts_nop 15\n\ts_nop 15\n\ts_nop 15\n\ts_nop 15\n\ts_nop 15\n\ts_nop 15\n\ts_nop 15" ::: "memory");
#endif
        ASBAR();
        ABAR_L();
        ASBAR();
        sl_prev = slot_t; slot_t = (slot_t == 4 * SLOTB) ? 0 : slot_t + SLOTB; sl_d = (sl_d == 4 * SLOTB) ? 0 : sl_d + SLOTB;
    }
    if (half == 0) ABAR_L();
    VRD(0, 0, sl_prev); PV_ALL(sl_prev);
    { auto rr = __builtin_amdgcn_permlane32_swap(__float_as_uint(l_reg), __float_as_uint(l_reg), false, false); l_reg = __uint_as_float(rr[0]) + __uint_as_float(rr[1]); }
    if (hi == 0) wsf[32 + r32] = l_reg;
    LDS_WAIT();
    { const int kbusy = sl_prev / SLOTB, pr = wid >> 1, fs = pr + (pr >= kbusy ? 1 : 0);
      LAS unsigned short* stg = (LAS unsigned short*)(shm + fs * SLOTB + (wid & 1) * (32 * DV * 2));
#pragma unroll
      for (int r = 0; r < 16; ++r) { const int orow = crow(r, hi); const float rl = __builtin_amdgcn_rcpf(wsf[32 + orow]);
#pragma unroll
          for (int d = 0; d < DB; ++d) stg[orow * DV + d * 32 + r32] = (unsigned short)f2bf(o[d][r] * rl); }
      LDS_WAIT();
      bf16* Ow = T.O + (size_t)(q0 + wid * 32) * T.op;
      constexpr int CPR = DV / 8, RPI = 64 / CPR;
#pragma unroll
      for (int i = 0; i < 32 / RPI; ++i) { const int row = i * RPI + lane / CPR, ch = lane % CPR;
          const v4u v = *(const LAS v4u*)(stg + row * DV + ch * 8); *(v4u*)(Ow + (size_t)row * T.op + ch * 8) = v; } }
    ABAR_L();
#undef DMA_NEXT
#undef PV_ALL
#undef SGB_MFMA_DS
#undef PV_BLK
#undef VFR
#undef VRD
#undef KLOAD
}
#undef ASBAR
#undef AMFMA
#undef ABAR_L
#undef ABAR_VL
}

__device__ __forceinline__ void p4_combine(const Args& a, int vcu, int G) {
    int tid_ = threadIdx.x; asm volatile("" : "+v"(tid_)); const int lane = tid_ & 63, wave = __builtin_amdgcn_readfirstlane(tid_ >> 6);
    const bf16* OD = (const bf16*)(a.ws + WS_OD); bf16* YC = (bf16*)(a.ws + WS_YC);
    float s1 = a.diff_lambda[lane] * a.diff_lambda[64 + lane], s2 = a.diff_lambda[128 + lane] * a.diff_lambda[192 + lane];
    s1 = wave_sum(s1); s2 = wave_sum(s2);
    const float lam = expf(s1) - expf(s2) + 0.2f;
    const int gw = vcu * NWAVES + wave, NGW = G * NWAVES, sub = lane >> 4, l16 = lane & 15;
    for (int it0 = gw * 4 + sub; it0 < NTOK * 4; it0 += 16 * NGW) {
        v4u w0[4], w1[4];
#pragma unroll
        for (int q = 0; q < 4; ++q) { const int it = it0 + q * 4 * NGW; if (it < NTOK * 4) { const int row = it >> 2, h = it & 3;
            w0[q] = *(const v4u*)(OD + (size_t)row * 1024 + (2 * h) * 128 + 8 * l16); w1[q] = *(const v4u*)(OD + (size_t)row * 1024 + (2 * h + 1) * 128 + 8 * l16); } else { w0[q] = (v4u){0u, 0u, 0u, 0u}; w1[q] = w0[q]; } }
#pragma unroll
        for (int q = 0; q < 4; ++q) { const int it = it0 + q * 4 * NGW; const int row = it >> 2, h = it & 3;
            float fa[8], fb[8]; unpack8(w0[q], fa); unpack8(w1[q], fb);
            f32x4 y0, y1; float ss = 0.f;
#pragma unroll
            for (int k = 0; k < 4; ++k) { y0[k] = fa[k] - lam * fb[k]; y1[k] = fa[4 + k] - lam * fb[4 + k]; ss += y0[k] * y0[k] + y1[k] * y1[k]; }
            ss += __shfl_xor(ss, 1); ss += __shfl_xor(ss, 2); ss += __shfl_xor(ss, 4); ss += __shfl_xor(ss, 8);
            const float r = rsqrtf(ss * (1.f / 128.f) + EPS);
            if (it < NTOK * 4) *(v4u*)(YC + (size_t)row * 1024 + 512 + h * 128 + 8 * l16) = pack8(y0 * r, y1 * r); }
    }
}

__device__ __forceinline__ void p7_router(const Args& a, LAS unsigned char* lds, int vcu, int G) {
    int tid = threadIdx.x; asm volatile("" : "+v"(tid)); const int lane = tid & 63, wave = __builtin_amdgcn_readfirstlane(tid >> 6);
    typedef float f32x16 __attribute__((ext_vector_type(16)));
    const bf16* X1 = (const bf16*)(a.ws + WS_X1); const float* WRT = (const float*)(a.ws + WS_WR); const float* SSQ2 = (const float*)(a.ws + WS_SSQ2);
    int* TOKL = (int*)(a.ws + WS_TOKL); int* SEL = (int*)(a.ws + WS_SEL); float* WTS = (float*)(a.ws + WS_WTS);
    gu32* ctl = (gu32*)(a.ws + WS_CTL); unsigned char* XQ = a.ws + WS_XQ;
    LAS float* xs = (LAS float*)(lds + RING_OFF) + wave * (32 * 65);
    LAS float* part = (LAS float*)(lds + RING_OFF + 8 * 32 * 65 * 4);
    LAS int* lcnt = (LAS int*)(lds + RING_OFF + 8 * 32 * 65 * 4 + 8 * 32 * 33 * 4);
    LAS float* r2s = (LAS float*)(lcnt + 64);
    for (int blk = vcu; blk < NTOK / 64; blk += G) {
        const int tok0 = blk * 64;
        const int grp = wave >> 2, kq = wave & 3, i = lane & 31, h = lane >> 5;
        if (tid < 64) { const int t = tok0 + tid; float ss = 0.f;
#pragma unroll
            for (int j = 0; j < 4; ++j) { const f32x4 p = *(const f32x4*)(SSQ2 + (size_t)t * 16 + 4 * j); ss += (p[0] + p[1]) + (p[2] + p[3]); }
            r2s[tid] = rsqrtf(ss * (1.f / DM) + EPS); }
        LDS_WAIT(); __syncthreads();
        f32x16 acc = f32x16{};
        const bf16* xg = X1 + (size_t)(tok0 + grp * 32 + (lane >> 3)) * DM + kq * 256 + 8 * (lane & 7);
        const float* wg = WRT + (size_t)i * DM + kq * 256 + 4 * h;
        v4u xq[4]; f32x4 wv[8];
#pragma unroll
        for (int j = 0; j < 4; ++j) xq[j] = *(const v4u*)(xg + (size_t)(8 * j) * DM);
#pragma unroll
        for (int c = 0; c < 8; ++c) wv[c] = *(const f32x4*)(wg + 8 * c);
#pragma unroll
        for (int p = 0; p < 4; ++p) {
            v4u xn[4]; f32x4 wn[8];
            if (p < 3) {
#pragma unroll
                for (int j = 0; j < 4; ++j) xn[j] = *(const v4u*)(xg + (size_t)(8 * j) * DM + 64 * (p + 1));
#pragma unroll
                for (int c = 0; c < 8; ++c) wn[c] = *(const f32x4*)(wg + 64 * (p + 1) + 8 * c); }
#pragma unroll
            for (int j = 0; j < 4; ++j) { float xv[8]; unpack8(xq[j], xv);
                LAS float* d = xs + ((lane >> 3) + 8 * j) * 65 + 8 * (lane & 7);
#pragma unroll
                for (int i2 = 0; i2 < 8; ++i2) d[i2] = xv[i2];
                const int tl = grp * 32 + (lane >> 3) + 8 * j; const float rr = r2s[tl];
                v2u o8; o8.x = pk4_fp8(xv[0] * rr, xv[1] * rr, xv[2] * rr, xv[3] * rr); o8.y = pk4_fp8(xv[4] * rr, xv[5] * rr, xv[6] * rr, xv[7] * rr);
                *(v2u*)(XQ + (size_t)(tok0 + tl) * 1024 + kq * 256 + 64 * p + 8 * (lane & 7)) = o8; }
            LDS_WAIT();
#pragma unroll
            for (int c = 0; c < 8; ++c)
#pragma unroll
                for (int q = 0; q < 4; ++q) acc = __builtin_amdgcn_mfma_f32_32x32x2f32(xs[i * 65 + 8 * c + 4 * h + q], wv[c][q], acc, 0, 0, 0);
            LDS_WAIT();
            if (p < 3) {
#pragma unroll
                for (int j = 0; j < 4; ++j) xq[j] = xn[j];
#pragma unroll
                for (int c = 0; c < 8; ++c) wv[c] = wn[c]; }
        }
        if (tid < 32) lcnt[tid] = 0;
#pragma unroll
        for (int r = 0; r < 16; ++r) part[(wave * 32 + ((r & 3) + 8 * (r >> 2) + 4 * h)) * 33 + i] = acc[r];
        LDS_WAIT(); __syncthreads();
        if (tid < 64) {
            const int t = tok0 + tid, g2 = tid >> 5, ti = tid & 31;
            const float r2 = r2s[tid];
            float lg[NE];
#pragma unroll
            for (int e = 0; e < NE; ++e) { float s = 0.f;
#pragma unroll
                for (int k4 = 0; k4 < 4; ++k4) s += part[((g2 * 4 + k4) * 32 + ti) * 33 + e];
                lg[e] = s * r2 + a.b_router[e]; }
            float tv[4]; int te[4];
#pragma unroll
            for (int r = 0; r < 4; ++r) { float best = -3.0e38f; int bi = 0;
#pragma unroll
                for (int e = 0; e < NE; ++e) { if (lg[e] > best) { best = lg[e]; bi = e; } }
                tv[r] = best; te[r] = bi;
#pragma unroll
                for (int e = 0; e < NE; ++e) if (e == bi) lg[e] = -3.0e38f; }
            float ev[4], sum = 0.f;
#pragma unroll
            for (int r = 0; r < 4; ++r) { ev[r] = __expf(tv[r] - tv[0]); sum += ev[r]; }
            const float rs = 1.f / sum;
            int ls[4];
#pragma unroll
            for (int r = 0; r < 4; ++r) { ls[r] = __hip_atomic_fetch_add(lcnt + te[r], 1, __ATOMIC_RELAXED, __HIP_MEMORY_SCOPE_WORKGROUP); WTS[t * 4 + r] = ev[r] * rs; }
            LDS_WAIT();
            __builtin_amdgcn_wave_barrier();
            if (tid < 32) { const int n = lcnt[tid]; lcnt[32 + tid] = n ? (int)__hip_atomic_fetch_add(ctl + CW_GCNT + tid, (unsigned)n, RLX_AGENT) : 0; }
            LDS_WAIT();
            __builtin_amdgcn_wave_barrier();
#pragma unroll
            for (int r = 0; r < 4; ++r) { const int slot = lcnt[32 + te[r]] + ls[r]; TOKL[te[r] * NTOK + slot] = t; SEL[t * 4 + r] = (te[r] << 16) | slot; }
        }
        LDS_WAIT(); __syncthreads();
    }
}

__device__ __forceinline__ void p10_final(const Args& a, LAS int* tab, int vcu, int G) {
    int tid_ = threadIdx.x; asm volatile("" : "+v"(tid_)); const int lane = tid_ & 63, wave = __builtin_amdgcn_readfirstlane(tid_ >> 6);
    const bf16* X1 = (const bf16*)(a.ws + WS_X1); const unsigned char* YB = a.ws + WS_YB; const int* SEL = (const int*)(a.ws + WS_SEL); const float* WTS = (const float*)(a.ws + WS_WTS);
    const int gw = vcu * NWAVES + wave, NGW = G * NWAVES;
    for (int t0 = gw; t0 < NTOK; t0 += 2 * NGW) {
        int sel[2][4]; float wt[2][4]; int tq[2];
#pragma unroll
        for (int q = 0; q < 2; ++q) { tq[q] = (t0 + q * NGW < NTOK) ? t0 + q * NGW : t0;
#pragma unroll
            for (int k = 0; k < 4; ++k) { sel[q][k] = SEL[tq[q] * 4 + k]; wt[q][k] = WTS[tq[q] * 4 + k] * (1.0f / Y8_SCALE); } }
        f32x4 v[2][4]; int yv[2][4][4];
#pragma unroll
        for (int q = 0; q < 2; ++q) { const GAS v2u* xr = (const GAS v2u*)(X1 + (size_t)tq[q] * DM) + lane;
#pragma unroll
            for (int j = 0; j < 4; ++j) { const v2u x2 = xr[64 * j]; v[q][j] = (f32x4){bf2f(x2.x & 0xffffu), bf2f(x2.x >> 16), bf2f(x2.y & 0xffffu), bf2f(x2.y >> 16)}; }
#pragma unroll
            for (int k = 0; k < 4; ++k) { const int e = sel[q][k] >> 16, slot = sel[q][k] & 0xffff;
                const size_t hrow = (size_t)tab[32 + e] * 256 + slot;
                const GAS int* yr = (const GAS int*)(YB + hrow * 1024) + lane;
#pragma unroll
                for (int j = 0; j < 4; ++j) yv[q][k][j] = yr[64 * j]; } }
#pragma unroll
        for (int q = 0; q < 2; ++q) {
#pragma unroll
            for (int k = 0; k < 4; ++k) { const float w = wt[q][k];
#pragma unroll
                for (int j = 0; j < 4; ++j) { const int y = yv[q][k][j];
                    const f32x2 lo = __builtin_amdgcn_cvt_pk_f32_fp8(y, false), hi = __builtin_amdgcn_cvt_pk_f32_fp8(y, true);
                    v[q][j].x += w * lo[0]; v[q][j].y += w * lo[1]; v[q][j].z += w * hi[0]; v[q][j].w += w * hi[1]; } }
            float s = 0.f;
#pragma unroll
            for (int j = 0; j < 4; ++j) s += (v[q][j].x * v[q][j].x + v[q][j].y * v[q][j].y) + (v[q][j].z * v[q][j].z + v[q][j].w * v[q][j].w);
            s = wave_sum(s);
            const float r = rsqrtf(s * (1.f / DM) + EPS);
            if (q == 0 || t0 + NGW < NTOK) { GAS f32x4* orow = (GAS f32x4*)(a.out + (size_t)tq[q] * DM) + lane;
#pragma unroll
                for (int j = 0; j < 4; ++j) { const f32x4 g = *((const GAS f32x4*)a.norm_final + lane + 64 * j); orow[64 * j] = v[q][j] * r * g; } } }
    }
}

constexpr int N_PHASES = 11;
__global__ void __launch_bounds__(NWAVES * 64, 2) mk_fwd(Args args) {
    extern __shared__ __attribute__((aligned(16))) unsigned char lds_raw[];
    LAS unsigned char* lds = (LAS unsigned char*)lds_raw;
    volatile LAS unsigned* MISC = (volatile LAS unsigned*)(lds + MISC_OFF);
    LAS int* tab = (LAS int*)(lds + TAB_OFF);
    const int tid = threadIdx.x;
    const int G = gridDim.x; const int bx = blockIdx.x; const int vcu = (G % 8 == 0) ? (bx % 8) * (G / 8) + bx / 8 : bx;
    unsigned char* ws = args.ws;
    gu32* ctl = (gu32*)(ws + WS_CTL);
    for (int u = tid; u < (LDS_BYTES - LDSCTL_OFF) / 4; u += NWAVES * 64) ((LAS unsigned*)(lds + LDSCTL_OFF))[u] = 0u;
    __syncthreads();
    const int lo = args.ph_lo, hi = args.ph_hi;
    const bool multi = (hi - lo) > 1;
    XcdBarrier bar; bar.bar = (unsigned*)(ctl + CW_BAR); bar.x = 0; bar.st = nullptr;
    if (multi) bar = xcd_barrier_post((unsigned*)(ctl + CW_BAR), MISC + 8);
#ifndef MK_ONLY
#define MK_ONLY (-1)
#endif
#define IN(k) ((MK_ONLY < 0 || MK_ONLY == (k)) && lo <= (k) && (k) < hi)
#define BOTH(k) (IN(k) && IN((k) + 1))
#ifdef MK_XBAR
#define SEAM(k) do { if (BOTH(k)) { xcd_barrier(bar); xcd_barrier(bar); } } while (0)
#else
#define SEAM(k) do { if (BOTH(k)) xcd_barrier(bar); } while (0)
#endif

    bf16* PROJ = (bf16*)(ws + WS_PROJ);
#ifndef MK_REPEAT
#define MK_REPEAT 0
#endif
#define RUN(k, ...) do { if (IN(k)) { __VA_ARGS__ if constexpr ((MK_REPEAT >> (k)) & 1) { xcd_barrier(bar); __VA_ARGS__ } SEAM(k); } } while (0)
    RUN(0, { p0_prologue(args, lds, vcu, G); });
    RUN(1, {
        { ProbPlain P{(const bf16*)(ws + WS_XB), (const bf16*)(ws + WS_WIN), DM, DM, 0, 0, DM};
          OrderIn16 S{G, vcu};
          EpiInProj E{PROJ, (bf16*)(ws + WS_KR), (const float*)(ws + WS_RX), (const f32x2*)(ws + WS_CS), (float*)(ws + WS_SSQQ), (float*)(ws + WS_SSQKV), (LAS float*)(lds + EPI_TAB_OFF), 0, 1.f};
          pg8::gemm_phase(lds + RING_OFF, P, S, E);
#ifdef PROBE_CALL1
          xcd_barrier(bar); pg8::gemm_phase(lds + RING_OFF, P, S, E); xcd_barrier(bar);
#endif
        }
        { ProbPlain8 P{ws + WS_XB8, ws + WS_WING8, 512, 512};
          OrderIn8 S{G, vcu};
          EpiInProj E{PROJ, (bf16*)(ws + WS_KR), (const float*)(ws + WS_RX), (const f32x2*)(ws + WS_CS), (float*)(ws + WS_SSQQ), (float*)(ws + WS_SSQKV), (LAS float*)(lds + EPI_TAB_OFF), 8, 1.f / (X8_SCALE * W8_SCALE)};
          pg8::gemm_phase(lds + RING_OFF, P, S, E);
#ifdef PROBE_CALL2
          xcd_barrier(bar); pg8::gemm_phase(lds + RING_OFF, P, S, E); xcd_barrier(bar);
#endif
        }
        { ProbQKV P{PROJ, (const bf16*)(ws + WS_WQ), (const bf16*)(ws + WS_WKV), 256, 256};
          OrderQKV2 S{G, vcu};
          EpiQKV E{(bf16*)(ws + WS_QM), (bf16*)(ws + WS_KN), (bf16*)(ws + WS_VM), (const float*)(ws + WS_SSQQ), (const float*)(ws + WS_SSQKV), (const f32x2*)(ws + WS_CS)};
          pg8::gemm_phase(lds + RING_OFF, P, S, E);
#ifdef PROBE_CALL3
          xcd_barrier(bar); pg8::gemm_phase(lds + RING_OFF, P, S, E); xcd_barrier(bar);
#endif
        } });
    RUN(3, {
        int tid3 = threadIdx.x; asm volatile("" : "+v"(tid3)); const int wave3 = __builtin_amdgcn_readfirstlane(tid3 >> 6), lane3 = tid3 & 63;
        const att::ConvArgs CV{args.w1, args.w2, args.norm_ffn, ws + WS_W1T, ws + WS_W2T, G * NWAVES, 0};
        att::ConvState cs{vcu * NWAVES + wave3, (vcu * NWAVES + wave3) / att::CONV_PER_E, (vcu * NWAVES + wave3) % att::CONV_PER_E, 0, 0, 0};
        for (int p = vcu; p < 512; p += G) {
            const int type = p >> 8, pp = p & 255, hd = pp >> 4, s = pp & 15, b = hd >> 3, hh = hd & 7;
            const size_t r0 = (size_t)b * SEQ;
            if (type == 0) {
                att::AttnP T{(const bf16*)(ws + WS_QM) + r0 * 768 + hh * 96, 768, (const bf16*)(ws + WS_KN) + r0 * 512 + hh * 64, 512, (const bf16*)(ws + WS_KR) + r0 * 32, 32,
                             (const bf16*)(ws + WS_VM) + r0 * 512 + hh * 64, 512, (bf16*)(ws + WS_YC) + r0 * 1024 + hh * 64, 1024, nullptr, 0};
                att::attn_unit<96, 64, false>(T, 31 - s, lds + RING_OFF, CV, cs);
                att::attn_unit<96, 64, false>(T, s, lds + RING_OFF, CV, cs);
            } else {
                att::AttnP T{PROJ + r0 * NPROJ + 512 + hh * 64, NPROJ, PROJ + r0 * NPROJ + 1024 + hh * 64, NPROJ, nullptr, 0,
                             PROJ + r0 * NPROJ + 1536 + (hh >> 1) * 128, NPROJ, (bf16*)(ws + WS_OD) + r0 * 1024 + hh * 128, 1024, args.rel_bias, hh >> 1};
                att::attn_unit<64, 128, true>(T, 31 - s, lds + RING_OFF, CV, cs);
                att::attn_unit<64, 128, true>(T, s, lds + RING_OFF, CV, cs);
            }
        }
#ifdef PROBE_ATT_MODE
        { int tid3b = threadIdx.x; asm volatile("" : "+v"(tid3b)); const int lane3 = tid3b & 63;
          LAS const float* stg_ = (LAS const float*)(lds + RING_OFF + CONV_OFF + wave3 * 4096);
          VM_WAIT();
          if (cs.pending) { att::conv_finish(CV, cs.ce, cs.cr, stg_, lane3); cs.pending = 0; }
          while (cs.next < att::CONV_NITEM) { LDS_WAIT(); att::conv_issue(CV, cs.ne, cs.nr, (unsigned)(uintptr_t)(lds + RING_OFF) + CONV_OFF + wave3 * 4096, lane3); VM_WAIT(); att::conv_finish(CV, cs.ne, cs.nr, stg_, lane3);
              cs.next += CV.stride; cs.nr += CV.stride; while (cs.nr >= att::CONV_PER_E) { cs.nr -= att::CONV_PER_E; ++cs.ne; } } }
        xcd_barrier(bar);
        const att::ConvArgs CV2{args.w1, args.w2, args.norm_ffn, ws + WS_YB, ws + WS_YB + 64 * MiB, G * NWAVES, PROBE_ATT_MODE};
        cs = att::ConvState{vcu * NWAVES + wave3, (vcu * NWAVES + wave3) / att::CONV_PER_E, (vcu * NWAVES + wave3) % att::CONV_PER_E, 0, 0, 0};
        if (PROBE_ATT_MODE == 9) cs.next = att::CONV_NITEM;
#define CV CV2
        for (int p = vcu; p < 512; p += G) {
            const int type = p >> 8, pp = p & 255, hd = pp >> 4, s = pp & 15, b = hd >> 3, hh = hd & 7;
            const size_t r0 = (size_t)b * SEQ;
            if (type == 0) {
                att::AttnP T{(const bf16*)(ws + WS_QM) + r0 * 768 + hh * 96, 768, (const bf16*)(ws + WS_KN) + r0 * 512 + hh * 64, 512, (const bf16*)(ws + WS_KR) + r0 * 32, 32,
                             (const bf16*)(ws + WS_VM) + r0 * 512 + hh * 64, 512, (bf16*)(ws + WS_YC) + r0 * 1024 + hh * 64, 1024, nullptr, 0};
                att::attn_unit<96, 64, false>(T, 31 - s, lds + RING_OFF, CV, cs);
                att::attn_unit<96, 64, false>(T, s, lds + RING_OFF, CV, cs);
            } else {
                att::AttnP T{PROJ + r0 * NPROJ + 512 + hh * 64, NPROJ, PROJ + r0 * NPROJ + 1024 + hh * 64, NPROJ, nullptr, 0,
                             PROJ + r0 * NPROJ + 1536 + (hh >> 1) * 128, NPROJ, (bf16*)(ws + WS_OD) + r0 * 1024 + hh * 128, 1024, args.rel_bias, hh >> 1};
                att::attn_unit<64, 128, true>(T, 31 - s, lds + RING_OFF, CV, cs);
                att::attn_unit<64, 128, true>(T, s, lds + RING_OFF, CV, cs);
            }
        }
#undef CV
#endif
        { int tid3b = threadIdx.x; asm volatile("" : "+v"(tid3b)); const int lane3 = tid3b & 63;
          LAS const float* stg_ = (LAS const float*)(lds + RING_OFF + CONV_OFF + wave3 * 4096);
          VM_WAIT();
          if (cs.pending) { att::conv_finish(CV, cs.ce, cs.cr, stg_, lane3); cs.pending = 0; }
          while (cs.next < att::CONV_NITEM) { LDS_WAIT(); att::conv_issue(CV, cs.ne, cs.nr, (unsigned)(uintptr_t)(lds + RING_OFF) + CONV_OFF + wave3 * 4096, lane3); VM_WAIT(); att::conv_finish(CV, cs.ne, cs.nr, stg_, lane3);
              cs.next += CV.stride; cs.nr += CV.stride; while (cs.nr >= att::CONV_PER_E) { cs.nr -= att::CONV_PER_E; ++cs.ne; } } } });
    RUN(4, { p4_combine(args, vcu, G); });
    RUN(5, {
        pg8::StaticOrder S; S.init(NTOK, DM, G, bx);
        ProbPlain P{(const bf16*)(ws + WS_YC), (const bf16*)(ws + WS_WUP), DM, DM, 0, 0, DM};
        EpiUp E{(bf16*)(ws + WS_MG), PROJ}; pg8::gemm_phase(lds + RING_OFF, P, S, E); });
    RUN(6, {
        ProbPlain P{(const bf16*)(ws + WS_MG), (const bf16*)(ws + WS_WOUT), DM, DM, 0, 0, DM};
        pg8::StaticOrder S; S.init(NTOK, DM, G, bx);
        EpiOut E{args.x, (bf16*)(ws + WS_X1), (float*)(ws + WS_SSQ2)};
        pg8::gemm_phase(lds + RING_OFF, P, S, E); });
    if (IN(7)) { p7_router(args, lds, vcu, G); SEAM(7); }
    RUN(8, {
        int tid8 = threadIdx.x; asm volatile("" : "+v"(tid8));
        build_expert_tab(ctl, tab, tid8);
        LAS unsigned short* tokT = (LAS unsigned short*)(lds + TOKT_OFF);
        EpiExp1 E{ws + WS_HB, args.b1, (LAS float*)(lds + EPI_TAB_OFF)};
        OrderExpert S{tab, 8, G, bx, 0, 1 << 30};
        pg8::Unit uu;
        if (!S.next(TOKT_UNITS, uu)) {
            ProbExp1<true> P{ws + WS_XQ, ws + WS_W1T, (const int*)(ws + WS_TOKL), tab, tokT, 512, 512};
            { const int hi8 = __builtin_amdgcn_readfirstlane(tid8 >> 8), r8 = tid8 & 255; int tk[TOKT_UNITS / 2];
              _Pragma("unroll") for (int k = 0; k < TOKT_UNITS / 2; ++k) { tk[k] = 0; if (S.next(2 * k + hi8, uu)) tk[k] = P.tok_g(uu, r8); }
              _Pragma("unroll") for (int k = 0; k < TOKT_UNITS / 2; ++k) tokT[(2 * k + hi8) * 256 + r8] = (unsigned short)tk[k]; }
            LDS_WAIT(); __syncthreads();
            pg8::gemm_phase(lds + RING_OFF, P, S, E);
        } else { ProbExp1<false> P{ws + WS_XQ, ws + WS_W1T, (const int*)(ws + WS_TOKL), tab, tokT, 512, 512}; pg8::gemm_phase(lds + RING_OFF, P, S, E); } });
    RUN(9, {
        int tid9 = threadIdx.x; asm volatile("" : "+v"(tid9));
        build_expert_tab(ctl, tab, tid9);
        ProbExp2 P{ws + WS_HB, ws + WS_W2T, 512, 512};
        OrderExpert S{tab, 4, G, bx, 0, 1 << 30};
        EpiExp2 E{ws + WS_YB, args.b2, (LAS float*)(lds + EPI_TAB_OFF)};
        pg8::gemm_phase(lds + RING_OFF, P, S, E);
#if defined(PROBE_P9_NOEPI) || defined(PROBE_P9_NOMMA)
        xcd_barrier(bar);
        { struct EpiNull { __device__ __forceinline__ void operator()(const f32x4 (&)[2][2][4][2], const pg8::Unit&, int, int, int, int) const {} } EN;
#ifdef PROBE_P9_NOMMA
          pg8::gemm_phase<EpiNull, OrderExpert, ProbExp2, true>(lds + RING_OFF, P, S, EN);
#else
          pg8::gemm_phase(lds + RING_OFF, P, S, EN);
#endif
        }
#endif
        });
    if (IN(10)) { int tid10 = threadIdx.x; asm volatile("" : "+v"(tid10)); build_expert_tab(ctl, tab, tid10); p10_final(args, tab, vcu, G); if constexpr ((MK_REPEAT >> 10) & 1) { xcd_barrier(bar); p10_final(args, tab, vcu, G); } }
#undef RUN
#undef IN
#undef BOTH
#undef SEAM
}

extern "C" void kernel_launch(void* const* d_in, const int* in_sizes, int n_in, void* d_out, int out_size, void* d_ws, size_t ws_size, hipStream_t stream) {
    static int grid = 0;
    if (grid == 0) {
        if (n_in != 22 || in_sizes[0] != NTOK * DM || out_size != NTOK * DM || ws_size < WS_END) { fprintf(stderr, "kernel_launch: unexpected shapes (n_in %d, ws %zu)\n", n_in, ws_size); grid = -1; return; }
        int dev = 0, cus = 0, per_cu = 0;
        if (hipGetDevice(&dev) != hipSuccess || hipDeviceGetAttribute(&cus, hipDeviceAttributeMultiprocessorCount, dev) != hipSuccess) { grid = -1; return; }
        if (hipFuncSetAttribute((const void*)mk_fwd, hipFuncAttributeMaxDynamicSharedMemorySize, LDS_BYTES) != hipSuccess) { fprintf(stderr, "kernel_launch: hipFuncSetAttribute failed\n"); grid = -1; return; }
        if (hipOccupancyMaxActiveBlocksPerMultiprocessor(&per_cu, (const void*)mk_fwd, NWAVES * 64, LDS_BYTES) != hipSuccess || per_cu < 1) { fprintf(stderr, "kernel_launch: occupancy query says %d\n", per_cu); }
        (void)hipGetLastError();
        grid = cus;
    }
    if (grid < 0) return;
    if (hipMemsetAsync((char*)d_ws + WS_CTL, 0, CTL_ZERO_BYTES, stream) != hipSuccess) return;
    Args a{};
    a.x = (const float*)d_in[0]; a.pos = (const int*)d_in[1]; a.norm_mix = (const float*)d_in[2]; a.w_in = (const float*)d_in[3]; a.mla_q_norm = (const float*)d_in[4];
    a.w_q_b = (const float*)d_in[5]; a.mla_kv_norm = (const float*)d_in[6]; a.w_kv_b = (const float*)d_in[7]; a.diff_lambda = (const float*)d_in[8]; a.diff_subln = (const float*)d_in[9];
    a.rel_bias = (const float*)d_in[10]; a.w_up_mla = (const float*)d_in[11]; a.w_up_diff = (const float*)d_in[12]; a.w_out = (const float*)d_in[13]; a.norm_ffn = (const float*)d_in[14];
    a.w_router = (const float*)d_in[15]; a.b_router = (const float*)d_in[16]; a.w1 = (const float*)d_in[17]; a.b1 = (const float*)d_in[18]; a.w2 = (const float*)d_in[19];
    a.b2 = (const float*)d_in[20]; a.norm_final = (const float*)d_in[21];
    a.out = (float*)d_out; a.ws = (unsigned char*)d_ws;
#if MK_N_LAUNCHES == 1
    a.ph_lo = 0; a.ph_hi = N_PHASES;
    hipLaunchKernelGGL(mk_fwd, dim3(grid), dim3(NWAVES * 64), LDS_BYTES, stream, a);
#else
    for (int p = 0; p < N_PHASES; ++p) { a.ph_lo = p; a.ph_hi = p + 1; hipLaunchKernelGGL(mk_fwd, dim3(grid), dim3(NWAVES * 64), LDS_BYTES, stream, a); }
#endif
}
```

```cpp
#include <hip/hip_runtime.h>
#include <hip/hip_bf16.h>
#include <cstdio>
#include <cstdint>
#include <cmath>

#ifndef MK_N_LAUNCHES
#define MK_N_LAUNCHES 1
#endif

namespace pg8 {
#define PG8_LAS __attribute__((address_space(3)))
typedef unsigned short bf16_t;
typedef short bf16x8 __attribute__((ext_vector_type(8)));
typedef float f32x4 __attribute__((ext_vector_type(4)));
typedef unsigned u32x4 __attribute__((ext_vector_type(4)));
typedef unsigned u32x2 __attribute__((ext_vector_type(2)));
constexpr int BM = 256, BK = 64, HALF = 128, HTB = HALF * BK * 2  , STAGE_BYTES = 8 * HTB, NXCD = 8, WGM = 8;

__host__ __device__ __forceinline__ int lds_byte(int r, int c) { const int st = (r >> 4) * 2 + (c >> 5), rr = r & 15, cc = c & 31, ob = rr * 64 + cc * 2; return st * 1024 + (ob ^ (((ob >> 9) & 1) << 5)); }
__host__ __device__ __forceinline__ void stage_rc(int b, int& R, int& C) { const int st = b / 1024, sb = b % 1024, swz = sb ^ (((sb >> 9) & 1) << 5); R = (st >> 1) * 16 + swz / 64; C = (st & 1) * 32 + (swz % 64) / 2; }
__host__ __device__ __forceinline__ int perm32(int rho) { const int n = rho >> 4, i = rho & 15; return 8 * (i >> 2) + 4 * n + (i & 3); }

struct Unit { int pm, pn, e, rt, ord; };

struct StaticOrder {
    int nM, nN, nwg, G, c;
    __host__ __device__ void init(int M, int N, int G_, int c_) { nM = M / BM; nN = N / BM; nwg = nM * nN; G = G_; c = c_; }
    __host__ __device__ bool next(int i, Unit& u) const {
        const long L = (long)i * G + c; if (L >= nwg) return false;
        int wgid = (int)L; { const int q = nwg / NXCD, r = nwg % NXCD, xcd = wgid % NXCD, off = wgid / NXCD; wgid = (xcd < r ? xcd * (q + 1) : r * (q + 1) + (xcd - r) * q) + off; }
        const int nig = WGM * nN, gid = wgid / nig, fm = gid * WGM, gsz = (nM - fm) < WGM ? (nM - fm) : WGM;
        u.pm = fm + ((wgid % nig) % gsz); u.pn = (wgid % nig) / gsz; u.e = 0; u.rt = 0; u.ord = i; return true;
    }
};

typedef float f32x2_cv __attribute__((ext_vector_type(2))); typedef __bf16 bf16x2_cv __attribute__((ext_vector_type(2)));
__device__ __forceinline__ unsigned cvt_pk_bf16(float lo, float hi) { const f32x2_cv v = {lo, hi}; const bf16x2_cv b = __builtin_convertvector(v, bf16x2_cv); return __builtin_bit_cast(unsigned, b); }

template <class E, class = void> struct epi_has_mid { static constexpr bool value = false; };
template <class E> struct epi_has_mid<E, decltype((void)E::HAS_MID)> { static constexpr bool value = true; };
template <class E, class = void> struct epi_has_pre { static constexpr bool value = false; };
template <class E> struct epi_has_pre<E, decltype((void)E::HAS_PRE)> { static constexpr bool value = true; };
template <class P, class = void> struct prob_is_fp8 { static constexpr bool value = false; };
template <class P> struct prob_is_fp8<P, decltype((void)P::FP8)> { static constexpr bool value = true; };
typedef int v8i_t __attribute__((ext_vector_type(8)));
typedef int v4i_t __attribute__((ext_vector_type(4)));
__device__ __forceinline__ v8i_t join8(const bf16x8& lo, const bf16x8& hi) { const v4i_t a = __builtin_bit_cast(v4i_t, lo), b = __builtin_bit_cast(v4i_t, hi); return __builtin_shufflevector(a, b, 0, 1, 2, 3, 4, 5, 6, 7); }
template <class Epi, class Sched, class Prob, bool NOMMA = false>
__device__ __forceinline__ void gemm_phase(PG8_LAS unsigned char* lds, const Prob& P, const Sched& S, const Epi& E) {
    int tid = threadIdx.x; asm volatile("" : "+v"(tid));
    const int wid = __builtin_amdgcn_readfirstlane(tid >> 6), lane = tid & 63, wr = wid >> 2, wc = wid & 3, fr = lane & 15, fq = lane >> 4;
    const int K = P.K, nt = K / BK;
    int Ra[2], Ca[2]; unsigned voffB[2];
#pragma unroll
    for (int i = 0; i < 2; ++i) { int R, C; stage_rc(tid * 16 + i * 8192, R, C); const int Rb = (R & ~31) + perm32(R & 31);
        Ra[i] = R; Ca[i] = C * 2; voffB[i] = (unsigned)(Rb * P.ldb + C) * 2u; }
    const size_t kstep = (size_t)(BK * 2);
    const size_t hstepB = (size_t)HALF * P.ldb * 2;
    const unsigned ldsw = (unsigned)wid * 1024u;
    constexpr bool F8 = prob_is_fp8<Prob>::value;
    constexpr int KOFF = F8 ? 16 : 1024;
    const int aoff = lds_byte(wr * 64 + fr, F8 ? fq * 16 : fq * 8), boff = lds_byte(wc * 32 + fr, F8 ? fq * 16 : fq * 8);
#define PG8_SA(b, h) (((b) * 2 + (h)) * HTB)
#define PG8_SB(b, h) ((4 + (b) * 2 + (h)) * HTB)
#define PG8_STAGE(bufoff, gbase, voff) do { _Pragma("unroll") for (int _i = 0; _i < 2; ++_i) \
        __builtin_amdgcn_global_load_lds((const unsigned*)((const char*)(gbase) + (voff)[_i]), (PG8_LAS unsigned*)(lds + (bufoff) + ldsw + _i * 8192), 16, 0, 0); } while (0)
#define PG8_LDA(dst, b, h) do { _Pragma("unroll") for (int m = 0; m < 4; ++m) { const v4i_t lo_ = *(const PG8_LAS v4i_t*)(lds + PG8_SA(b, h) + aoff + m * 2048), hi_ = *(const PG8_LAS v4i_t*)(lds + PG8_SA(b, h) + aoff + m * 2048 + KOFF); \
        dst[m] = __builtin_shufflevector(lo_, hi_, 0, 1, 2, 3, 4, 5, 6, 7); } } while (0)
#define PG8_LDB(dst, b, h) do { _Pragma("unroll") for (int n = 0; n < 2; ++n) { const v4i_t lo_ = *(const PG8_LAS v4i_t*)(lds + PG8_SB(b, h) + boff + n * 2048), hi_ = *(const PG8_LAS v4i_t*)(lds + PG8_SB(b, h) + boff + n * 2048 + KOFF); \
        dst[n] = __builtin_shufflevector(lo_, hi_, 0, 1, 2, 3, 4, 5, 6, 7); } } while (0)
#define PG8_LO(x) __builtin_bit_cast(bf16x8, __builtin_shufflevector(x, x, 0, 1, 2, 3))
#define PG8_HI(x) __builtin_bit_cast(bf16x8, __builtin_shufflevector(x, x, 4, 5, 6, 7))
#define PG8_MMA(FIRST, ai, bj, At, Bt) do { __builtin_amdgcn_s_setprio(1); if constexpr (!NOMMA) { \
        if constexpr (F8) { _Pragma("unroll") for (int m = 0; m < 4; ++m) _Pragma("unroll") for (int n = 0; n < 2; ++n) {   \
            if constexpr (FIRST) asm volatile("v_mfma_scale_f32_16x16x128_f8f6f4 %0, %1, %2, 0, %3, %3 op_sel_hi:[0,0,0]" : "=&v"(acc[ai][bj][m][n]) : "v"(Bt[n]), "v"(At[m]), "v"(sc8)); \
            else asm volatile("v_mfma_scale_f32_16x16x128_f8f6f4 %0, %1, %2, %0, %3, %3 op_sel_hi:[0,0,0]" : "+v"(acc[ai][bj][m][n]) : "v"(Bt[n]), "v"(At[m]), "v"(sc8)); } } \
        else {   \
            _Pragma("unroll") for (int m = 0; m < 4; ++m) _Pragma("unroll") for (int n = 0; n < 2; ++n) { \
                if constexpr (FIRST) asm volatile("v_mfma_f32_16x16x32_bf16 %0, %1, %2, 0" : "=&v"(acc[ai][bj][m][n]) : "v"(PG8_LO(Bt[n])), "v"(PG8_LO(At[m]))); \
                else asm volatile("v_mfma_f32_16x16x32_bf16 %0, %1, %2, %0" : "+v"(acc[ai][bj][m][n]) : "v"(PG8_LO(Bt[n])), "v"(PG8_LO(At[m]))); } \
            _Pragma("unroll") for (int m = 0; m < 4; ++m) _Pragma("unroll") for (int n = 0; n < 2; ++n) \
                asm volatile("v_mfma_f32_16x16x32_bf16 %0, %1, %2, %0" : "+v"(acc[ai][bj][m][n]) : "v"(PG8_HI(Bt[n])), "v"(PG8_HI(At[m]))); } } \
        __builtin_amdgcn_s_setprio(0); } while (0)
#define PG8_WAIT_V(n) asm volatile("s_waitcnt vmcnt(" #n ")" ::: "memory")
#define PG8_WAIT_L(n) asm volatile("s_waitcnt lgkmcnt(" #n ")" ::: "memory")
#define PG8_BAR __builtin_amdgcn_s_barrier()
#define PG8_SCHED __builtin_amdgcn_sched_barrier(0)
#define PG8_AOFF(dst, u) do { _Pragma("unroll") for (int _h = 0; _h < 2; ++_h) _Pragma("unroll") for (int _i = 0; _i < 2; ++_i) { dst[_h][_i] = P.a_off(u, _h * HALF + Ra[_i]) + (unsigned)Ca[_i]; asm volatile("" : "+v"(dst[_h][_i])); } } while (0)
    Unit cur, nxt; int ui = 0;
    if (!S.next(0, cur)) return;
    f32x4 acc[2][2][4][2];
#define PG8_ZERO_ACC do { _Pragma("unroll") for (int a = 0; a < 2; ++a) _Pragma("unroll") for (int b = 0; b < 2; ++b) _Pragma("unroll") for (int m = 0; m < 4; ++m) _Pragma("unroll") for (int n = 0; n < 2; ++n) acc[a][b][m][n] = (f32x4){0.f, 0.f, 0.f, 0.f}; } while (0)
    const int sc8 = 0x7F7F7F7F;
    v8i_t At[4], B0[2], B1[2];
    unsigned cvA[2][2], nvA[2][2];
    PG8_AOFF(cvA, cur);
    const char* const cA = P.a_base(); const char* cB = P.b_base(cur);
    PG8_STAGE(PG8_SB(0, 0), cB, voffB); PG8_STAGE(PG8_SB(0, 1), cB + hstepB, voffB); PG8_STAGE(PG8_SA(0, 0), cA, cvA[0]); PG8_STAGE(PG8_SA(0, 1), cA, cvA[1]);
    if (wr == 1) PG8_BAR;
    PG8_WAIT_V(2); PG8_BAR;
    PG8_STAGE(PG8_SB(1, 0), cB + kstep, voffB); PG8_STAGE(PG8_SA(1, 0), cA + kstep, cvA[0]); PG8_STAGE(PG8_SB(1, 1), cB + hstepB + kstep, voffB);
    PG8_WAIT_V(6); PG8_BAR;
    for (;;) {
        const bool has_next = S.next(ui + 1, nxt);
        const char* nB = cB;
        if (has_next) { nB = P.b_base(nxt); PG8_AOFF(nvA, nxt); }
        else {
#pragma unroll
            for (int _h = 0; _h < 2; ++_h)
#pragma unroll
                for (int _i = 0; _i < 2; ++_i) nvA[_h][_i] = cvA[_h][_i];
        }
        if constexpr (epi_has_pre<Epi>::value) E.pre(cur, wid, lane);
#define PG8_KITER(FIRST) do { \
            if constexpr (!(FIRST) && epi_has_mid<Epi>::value) { if (t == nt / 2) { asm volatile("s_nop 15\n\ts_nop 3" ::: "memory"); E.mid(acc, cur, wr, wc, fr, fq); } }        \
            const bool last = (t == nt - 2); \
            const char* a1 = cA + (size_t)(t + 1) * kstep;                                             \
            const char* a2 = last ? cA : cA + (size_t)(t + 2) * kstep; const char* b2 = last ? nB : cB + (size_t)(t + 2) * kstep;     \
            const char* a3 = a2 + kstep; const char* b3 = b2 + kstep;                                \
            unsigned xv0[2], xv1[2];                                                                \
            _Pragma("unroll") for (int _i = 0; _i < 2; ++_i) { xv0[_i] = last ? nvA[0][_i] : cvA[0][_i]; xv1[_i] = last ? nvA[1][_i] : cvA[1][_i]; } \
              \
            PG8_LDB(B0, 0, 0); PG8_LDB(B1, 0, 1); PG8_SCHED; PG8_LDA(At, 0, 0); PG8_STAGE(PG8_SA(1, 1), a1, cvA[1]); \
            PG8_WAIT_V(8); PG8_WAIT_L(0); PG8_BAR; PG8_MMA(FIRST, 0, 0, At, B0); PG8_MMA(FIRST, 0, 1, At, B1); PG8_BAR; PG8_SCHED; \
              \
            PG8_LDA(At, 0, 1); PG8_STAGE(PG8_SB(0, 0), b2, voffB); PG8_STAGE(PG8_SB(0, 1), b2 + hstepB, voffB); PG8_STAGE(PG8_SA(0, 0), a2, xv0); \
            PG8_WAIT_V(8); PG8_WAIT_L(0); PG8_BAR; PG8_MMA(FIRST, 1, 0, At, B0); PG8_MMA(FIRST, 1, 1, At, B1); PG8_BAR; PG8_SCHED; \
              \
            PG8_LDB(B0, 1, 0); PG8_LDB(B1, 1, 1); PG8_SCHED; PG8_LDA(At, 1, 0); PG8_STAGE(PG8_SA(0, 1), a2, xv1); \
            PG8_WAIT_V(8); PG8_WAIT_L(0); PG8_BAR; PG8_MMA(false, 0, 0, At, B0); PG8_MMA(false, 0, 1, At, B1); PG8_BAR; PG8_SCHED; \
              \
            PG8_LDA(At, 1, 1); PG8_STAGE(PG8_SB(1, 0), b3, voffB); PG8_STAGE(PG8_SB(1, 1), b3 + hstepB, voffB); PG8_STAGE(PG8_SA(1, 0), a3, xv0); \
            PG8_WAIT_V(8); PG8_WAIT_L(0); PG8_BAR; PG8_MMA(false, 1, 0, At, B0); PG8_MMA(false, 1, 1, At, B1); PG8_BAR; PG8_SCHED; \
        } while (0)
        { const int t = 0; PG8_KITER(true); }
        for (int t = 2; t < nt; t += 2) { PG8_KITER(false); }
#undef PG8_KITER
        if (wr == 0) PG8_BAR;
        asm volatile("s_nop 15\n\ts_nop 3" ::: "memory");
        E(acc, cur, wr, wc, fr, fq);
#ifdef PG8_DUP_EPI
        E(acc, cur, wr, wc, fr, fq);
#endif
        if (!has_next) break;
        cur = nxt; cB = nB; ++ui;
#pragma unroll
        for (int _h = 0; _h < 2; ++_h)
#pragma unroll
            for (int _i = 0; _i < 2; ++_i) cvA[_h][_i] = nvA[_h][_i];
        if (wr == 1) PG8_BAR;
    }
    PG8_WAIT_V(0);
    PG8_BAR;
#undef PG8_SA
#undef PG8_SB
#undef PG8_STAGE
#undef PG8_LDA
#undef PG8_LDB
#undef PG8_LO
#undef PG8_HI
#undef PG8_MMA
#undef PG8_WAIT_V
#undef PG8_WAIT_L
#undef PG8_BAR
#undef PG8_SCHED
#undef PG8_AOFF
#undef PG8_ZERO_ACC
}
}

#define GAS __attribute__((address_space(1)))
#define LAS __attribute__((address_space(3)))
typedef unsigned short bf16;
typedef unsigned v4u __attribute__((ext_vector_type(4)));
typedef unsigned v2u __attribute__((ext_vector_type(2)));
typedef float f32x4 __attribute__((ext_vector_type(4)));
typedef float f32x2 __attribute__((ext_vector_type(2)));
typedef GAS unsigned gu32;
#define RLX_AGENT __ATOMIC_RELAXED, __HIP_MEMORY_SCOPE_AGENT
#define LDS_WAIT() asm volatile("s_waitcnt lgkmcnt(0)" ::: "memory")
#define VM_WAIT() asm volatile("s_waitcnt vmcnt(0)" ::: "memory")
__device__ __forceinline__ unsigned f2bf(float f) { unsigned u = __builtin_bit_cast(unsigned, f); return (u + 0x7fffu + ((u >> 16) & 1u)) >> 16; }
__device__ __forceinline__ unsigned pk2(float lo, float hi) { return f2bf(lo) | (f2bf(hi) << 16); }
__device__ __forceinline__ float bf2f(unsigned h) { return __builtin_bit_cast(float, h << 16); }
__device__ __forceinline__ float wave_sum(float v) {
#pragma unroll
    for (int o = 1; o < 64; o <<= 1) v += __shfl_xor(v, o);
    return v;
}

constexpr int NWAVES = 8;
constexpr int NTOK = 16384, SEQ = 8192, DM = 1024, NPROJ = 4096, NE = 32, INT_TOTAL = 4000;
constexpr float EPS = 1e-5f, LOG2E = 1.4426950408889634f;
constexpr float C2D = 0.125f * LOG2E;
constexpr float C2M = 0.10206207261596577f * LOG2E;
constexpr float W8_SCALE = 32.0f;
constexpr float X8_SCALE = 16.0f;
constexpr float H8_SCALE = 4.0f;
constexpr float Y8_SCALE = 16.0f;
constexpr int HCAP = 73728;

constexpr size_t MiB = 1u << 20, KiB = 1u << 10;
constexpr size_t WS_CTL = 0, CTL_ZERO_BYTES = 32 * KiB;
constexpr size_t WS_WQ = 1 * MiB, WS_WKV = 1 * MiB + 512 * KiB, WS_WUP = 2 * MiB, WS_WOUT = 4 * MiB, WS_WR = 6 * MiB, WS_RX = 6 * MiB + 256 * KiB;
constexpr size_t WS_SSQQ = 6 * MiB + 512 * KiB, WS_SSQKV = 6 * MiB + 768 * KiB, WS_SSQ2 = 7 * MiB, WS_WIN = 8 * MiB, WS_CS = 16 * MiB, WS_TOKL = 18 * MiB;
constexpr size_t WS_SEL = 20 * MiB, WS_WTS = 20 * MiB + 256 * KiB, WS_R2 = 20 * MiB + 512 * KiB, WS_KR = 21 * MiB;
constexpr size_t WS_W1T = 24 * MiB, WS_W2T = 152 * MiB, WS_XB = 216 * MiB, WS_PROJ = 248 * MiB, WS_QM = 376 * MiB, WS_KN = 400 * MiB, WS_VM = 416 * MiB;
constexpr size_t WS_YC = 432 * MiB, WS_OD = 464 * MiB, WS_T1 = 496 * MiB, WS_MG = 528 * MiB, WS_X1 = 560 * MiB, WS_X1B = 624 * MiB, WS_YB = 656 * MiB, WS_END = 800 * MiB;
constexpr size_t WS_XQ = WS_X1B;
constexpr size_t WS_XB8 = WS_X1B + 16 * MiB;
constexpr size_t WS_WING8 = WS_WIN + 4 * MiB;
constexpr size_t WS_HB = WS_PROJ;
static_assert(WS_HB + (size_t)HCAP * 1024 * 2 <= WS_KN, "HB overlay");
constexpr int CW_TMO = 0, CW_GCNT = 64  , CW_BAR = 4096;

constexpr int RING_OFF = 0, RING_BYTES = 131072;
constexpr int CONV_OFF = 125440;
constexpr int LDSCTL_OFF = 155 * 1024, MISC_OFF = LDSCTL_OFF + 320;
constexpr int TAB_OFF = LDSCTL_OFF + 1024;
constexpr int EPI_TAB_OFF = 140 * 1024;
constexpr int LDS_BYTES = 163840;
#define XB_TMO      128
#define XB_XCNT(j)  (256  + 64 * (j))
#define XB_XSUB(j)  (1280 + 64 * (j))
#define XB_XGEN(j)  (2304 + 64 * (j))
#define XB_TOP      3328
#define XB_TOPGEN   3392
#define XCD_BAR_WORDS 3456
#define XB_SPIN_CAP (1u << 18)

__device__ __forceinline__ unsigned xb_ld(unsigned* p)              { return __hip_atomic_load(p, __ATOMIC_RELAXED, __HIP_MEMORY_SCOPE_AGENT); }
__device__ __forceinline__ unsigned xb_add(unsigned* p, unsigned v) { return __hip_atomic_fetch_add(p, v, __ATOMIC_RELAXED, __HIP_MEMORY_SCOPE_AGENT); }
__device__ __forceinline__ unsigned xb_xcc_id() { return (unsigned)__builtin_amdgcn_s_getreg((3 << 11) | 20) & 0xFu; }
#define XB_SPIN(cond, bar) do { unsigned _sp = 0; while (cond) { __builtin_amdgcn_s_sleep(1); \
    if ((++_sp & 255u) == 0u) { if (xb_ld(&(bar)[XB_TMO])) break; if (_sp > XB_SPIN_CAP) { atomicAdd(&(bar)[XB_TMO], 1u); break; } } } } while (0)

struct XcdBarrier {
    unsigned* bar; unsigned x;
    volatile LAS unsigned* st;
};

__device__ __forceinline__ XcdBarrier xcd_barrier_post(unsigned* bar, volatile LAS unsigned* st) {
    XcdBarrier b; b.bar = bar; b.x = xb_xcc_id(); b.st = st;
    if (threadIdx.x == 0) (void)xb_add(&bar[XB_XCNT(b.x)], 1u);
    return b;
}
__device__ __forceinline__ void xcd_barrier_complete(unsigned* bar, unsigned x, unsigned& nloc, unsigned& nx) {
    const unsigned G = gridDim.x * gridDim.y * gridDim.z;
    unsigned sum, cnt, mine, sp = 0u;
    for (;;) {
        sum = 0u; cnt = 0u; mine = 0u;
#pragma unroll
        for (unsigned j = 0; j < 16; ++j) { const unsigned c = xb_ld(&bar[XB_XCNT(j)]); sum += c; cnt += (c > 0u) ? 1u : 0u; mine = (j == x) ? c : mine; }
        if (sum == G) break;
        __builtin_amdgcn_s_sleep(1);
        if ((++sp & 255u) == 0u) { if (xb_ld(&bar[XB_TMO])) break; if (sp > XB_SPIN_CAP) { atomicAdd(&bar[XB_TMO], 1u); break; } }
    }
    nloc = mine > 0u ? mine : 1u; nx = cnt > 0u ? cnt : 1u;
}

__device__ __forceinline__ void xcd_barrier(const XcdBarrier& b) {
    asm volatile("s_waitcnt vmcnt(0)" ::: "memory");
    __syncthreads();
    if (threadIdx.x == 0) {
        unsigned* bar = b.bar;
        __builtin_amdgcn_s_waitcnt(0);
        unsigned nloc = b.st[0], nx = b.st[1];
        if (nloc == 0u) { xcd_barrier_complete(bar, b.x, nloc, nx); b.st[0] = nloc; b.st[1] = nx; }
        const unsigned old = xb_add(&bar[XB_XSUB(b.x)], 1u);
        const unsigned gen = old / nloc;
        if (old + 1u == (gen + 1u) * nloc) {
            __builtin_amdgcn_fence(__ATOMIC_RELEASE, "agent");
            asm volatile("s_waitcnt vmcnt(0)" ::: "memory");
            const unsigned og = xb_add(&bar[XB_TOP], 1u);
            const unsigned tg = og / nx;
            if (og + 1u == (tg + 1u) * nx) xb_add(&bar[XB_TOPGEN], 1u);
            else XB_SPIN(xb_ld(&bar[XB_TOPGEN]) == tg, bar);
            __builtin_amdgcn_fence(__ATOMIC_ACQUIRE, "agent");
            xb_add(&bar[XB_XGEN(b.x)], 1u);
            asm volatile("s_waitcnt vmcnt(0)" ::: "memory");
        } else {
            XB_SPIN(xb_ld(&bar[XB_XGEN(b.x)]) == gen, bar);
            __builtin_amdgcn_fence(__ATOMIC_ACQUIRE, "agent");
            asm volatile("s_waitcnt vmcnt(0)" ::: "memory");
        }
    }
    __syncthreads();
}

struct Args {
    const float* x; const int* pos; const float* norm_mix; const float* w_in; const float* mla_q_norm; const float* w_q_b; const float* mla_kv_norm; const float* w_kv_b;
    const float* diff_lambda; const float* diff_subln; const float* rel_bias; const float* w_up_mla; const float* w_up_diff; const float* w_out; const float* norm_ffn;
    const float* w_router; const float* b_router; const float* w1; const float* b1; const float* w2; const float* b2; const float* norm_final;
    float* out; unsigned char* ws; int ph_lo, ph_hi;
};

__device__ __forceinline__ int rope_dim(int p) { return 16 * ((p >> 2) & 1) + 4 * (p >> 3) + (p & 3); }

__device__ __forceinline__ unsigned pk4_fp8(float a, float b, float c, float d) { int w = __builtin_amdgcn_cvt_pk_fp8_f32(a, b, 0, false); w = __builtin_amdgcn_cvt_pk_fp8_f32(c, d, w, true); return (unsigned)w; }
template <bool OUT8, class Map>
__device__ __forceinline__ void tr_item(const float* src, int lds_, int Ksrc, void* dstv, int ldd, int koff, const Map& map, LAS float* scr, int kb, int nb, int lane) {
    const int k0 = 64 * kb, n0 = 64 * nb, c = lane & 15, kq = lane >> 4;
    const int col = map.col(n0 + 4 * c);
    f32x4 v[16];
#pragma unroll
    for (int j = 0; j < 16; ++j) { const int k = k0 + 4 * j + kq; v[j] = (f32x4){0.f, 0.f, 0.f, 0.f};
        if (col >= 0 && k < Ksrc) v[j] = *(const GAS f32x4*)(src + (size_t)k * lds_ + col); }
#pragma unroll
    for (int j = 0; j < 16; ++j) { const int k = k0 + 4 * j + kq; const float sc = (k < Ksrc) ? map.scale(k) : 0.f;
#pragma unroll
        for (int i = 0; i < 4; ++i) scr[(4 * c + i) * 65 + 4 * j + kq] = v[j][i] * sc; }
    LDS_WAIT(); asm volatile("" ::: "memory");
    const int cc = lane & 7;
#pragma unroll
    for (int jj = 0; jj < 8; ++jj) { const int n = (lane >> 3) + 8 * jj; const LAS float* s = scr + n * 65 + 8 * cc;
        if constexpr (OUT8) { v2u o; o.x = pk4_fp8(s[0], s[1], s[2], s[3]); o.y = pk4_fp8(s[4], s[5], s[6], s[7]);
            *(GAS v2u*)((unsigned char*)dstv + (size_t)(n0 + n) * ldd + koff + k0 + 8 * cc) = o; }
        else { v4u o; o.x = pk2(s[0], s[1]); o.y = pk2(s[2], s[3]); o.z = pk2(s[4], s[5]); o.w = pk2(s[6], s[7]);
            *(GAS v4u*)((bf16*)dstv + (size_t)(n0 + n) * ldd + koff + k0 + 8 * cc) = o; } }
    LDS_WAIT(); asm volatile("" ::: "memory");
}
struct MapWin { const float* g; __device__ int col(int n) const { if (n < 384) return n; if (n < 416) return 384 + rope_dim(n - 384); if (n < 512) return -1; if (n < 2048) return n - 96; return 1952 + ((n >> 7) & 1) * 1024 + ((n - 2048) >> 8) * 128 + (n & 127); }        __device__ float scale(int k) const { return g[k]; } };
struct MapWin8 { const float* g; __device__ int col(int n) const { return 1952 + ((n >> 7) & 1) * 1024 + ((n - 2048) >> 8) * 128 + (n & 127); } __device__ float scale(int k) const { return g[k] * W8_SCALE; } };
struct MapWq { const float* g; __device__ int col(int n) const { if (n < 512) return (n >> 6) * 96 + (n & 63); const int h = (n - 512) >> 5; return h * 96 + 64 + rope_dim((n - 512) & 31); } __device__ float scale(int k) const { return g[k]; } };
struct MapWkv { const float* g; __device__ int col(int n) const { if (n < 512) return (n >> 6) * 128 + (n & 63); return ((n - 512) >> 6) * 128 + 64 + (n & 63); } __device__ float scale(int k) const { return g[k]; } };
struct MapId { __device__ int col(int n) const { return n; } __device__ float scale(int) const { return 1.f; } };
struct MapW2 { __device__ int col(int n) const { return n; } __device__ float scale(int) const { return W8_SCALE; } };
struct MapUpDiff { const float* g; __device__ int col(int n) const { return n; } __device__ float scale(int k) const { return 0.8f * g[k & 127]; } };
struct MapW1 { const float* g; __device__ int col(int n) const { return ((n >> 7) & 1) * 1024 + (n >> 8) * 128 + (n & 127); } __device__ float scale(int k) const { return g[k] * W8_SCALE; } };

__device__ __forceinline__ void rope_cs(int pos, int j, float& c, float& s) {
    const float freq = exp2f(-(float)j * (13.287712379549449f / 16.0f));
    const float angf = (float)pos * freq;
    const double a = (double)angf;
    const double TWO_PI = 6.283185307179586476925286766559;
    const double r = a - TWO_PI * rint(a / TWO_PI);
    const float rf = (float)r;
    c = __cosf(rf); s = __sinf(rf);
}

__device__ __forceinline__ void p0_prologue(const Args& a, LAS unsigned char* lds, int vcu, int G) {
    int tid = threadIdx.x; asm volatile("" : "+v"(tid)); const int lane = tid & 63, wave = __builtin_amdgcn_readfirstlane(tid >> 6);
    unsigned char* ws = a.ws;
    LAS float* scr = (LAS float*)(lds + RING_OFF + wave * 16640);
    const int gw = vcu * NWAVES + wave, NGW = G * NWAVES;
    { constexpr int I_IN = 64 * 16, I_Q = 12 * 4, I_KV = 16 * 4, I_UA = 16 * 8, I_UB = 16 * 8, I_O = 16 * 16, TOT = I_IN + I_Q + I_KV + I_UA + I_UB + I_O;
      const MapWin mwin{a.norm_mix}; const MapWin8 mwin8{a.norm_mix}; const MapWq mwq{a.mla_q_norm}; const MapWkv mwkv{a.mla_kv_norm}; const MapId mi{}; const MapUpDiff mud{a.diff_subln};
      for (int it = gw; it < TOT; it += NGW) {
          int r = it;
          if (r < I_IN) { if ((r >> 4) < 32) tr_item<false>(a.w_in, INT_TOTAL, 1024, (bf16*)(ws + WS_WIN), 1024, 0, mwin, scr, r & 15, r >> 4, lane);
                          else tr_item<true>(a.w_in, INT_TOTAL, 1024, ws + WS_WING8 - (size_t)2048 * 1024, 1024, 0, mwin8, scr, r & 15, r >> 4, lane);
                          continue; } r -= I_IN;
          if (r < I_Q) { tr_item<false>(a.w_q_b, 768, 256, (bf16*)(ws + WS_WQ), 256, 0, mwq, scr, r & 3, r >> 2, lane); continue; } r -= I_Q;
          if (r < I_KV) { tr_item<false>(a.w_kv_b, 1024, 128, (bf16*)(ws + WS_WKV), 256, 0, mwkv, scr, r & 3, r >> 2, lane); continue; } r -= I_KV;
          if (r < I_UA) { tr_item<false>(a.w_up_mla, 1024, 512, (bf16*)(ws + WS_WUP), 1024, 0, mi, scr, r & 7, r >> 3, lane); continue; } r -= I_UA;
          if (r < I_UB) { tr_item<false>(a.w_up_diff, 1024, 512, (bf16*)(ws + WS_WUP), 1024, 512, mud, scr, r & 7, r >> 3, lane); continue; } r -= I_UB;
          tr_item<false>(a.w_out, 1024, 1024, (bf16*)(ws + WS_WOUT), 1024, 0, mi, scr, r & 15, r >> 4, lane);
      } }
    { bf16* XB = (bf16*)(ws + WS_XB); float* RX = (float*)(ws + WS_RX);
      for (int m0 = gw; m0 < NTOK; m0 += 2 * NGW) {
          f32x4 v[2][4];
#pragma unroll
          for (int q = 0; q < 2; ++q) { const int m = m0 + q * NGW; const GAS f32x4* xr = (const GAS f32x4*)(a.x + (size_t)(m < NTOK ? m : m0) * DM) + lane;
#pragma unroll
              for (int j = 0; j < 4; ++j) v[q][j] = xr[64 * j]; }
#pragma unroll
          for (int q = 0; q < 2; ++q) { const int m = m0 + q * NGW; float s = 0.f;
#pragma unroll
              for (int j = 0; j < 4; ++j) s += (v[q][j].x * v[q][j].x + v[q][j].y * v[q][j].y) + (v[q][j].z * v[q][j].z + v[q][j].w * v[q][j].w);
              s = wave_sum(s);
              if (m < NTOK) { if (lane == 0) RX[m] = rsqrtf(s * (1.f / DM) + EPS);
                  GAS unsigned long long* o8 = (GAS unsigned long long*)(XB + (size_t)m * DM) + lane;
#pragma unroll
                  for (int j = 0; j < 4; ++j) o8[64 * j] = (unsigned long long)pk2(v[q][j].x, v[q][j].y) | ((unsigned long long)pk2(v[q][j].z, v[q][j].w) << 32);
                  GAS unsigned* o4 = (GAS unsigned*)(ws + WS_XB8 + (size_t)m * DM) + lane;
#pragma unroll
                  for (int j = 0; j < 4; ++j) o4[64 * j] = pk4_fp8(v[q][j].x * X8_SCALE, v[q][j].y * X8_SCALE, v[q][j].z * X8_SCALE, v[q][j].w * X8_SCALE); } }
      } }
    { f32x2* CS = (f32x2*)(ws + WS_CS); float* WR = (float*)(ws + WS_WR);
      const int gt = vcu * NWAVES * 64 + tid, NGT = G * NWAVES * 64;
      for (int i = gt; i < NTOK * 16; i += NGT) { float c, s; rope_cs(a.pos[i >> 4], i & 15, c, s); CS[i] = (f32x2){c, s}; }
      for (int i = gt; i < DM * NE; i += NGT) { const int e = i >> 10, k = i & 1023; WR[i] = a.w_router[k * NE + e] * a.norm_ffn[k]; }
    }
}

using pg8::Unit; using pg8::HALF;
struct ProbPlain {
    const bf16* A; const bf16* Bt; int lda, ldb, acol, bcol, K;
    __device__ __forceinline__ const char* a_base() const { return (const char*)A; }
    __device__ __forceinline__ unsigned a_off(const Unit& u, int r) const { return (unsigned)(((u.pm * 256 + r) * lda + acol) * 2); }
    __device__ __forceinline__ const char* b_base(const Unit& u) const { return (const char*)(Bt + (size_t)u.pn * 256 * ldb + bcol); }
};
struct ProbPlain8 {
    static constexpr bool FP8 = true;
    const unsigned char* A; const unsigned char* Bt; int K, ldb;
    __device__ __forceinline__ const char* a_base() const { return (const char*)A; }
    __device__ __forceinline__ unsigned a_off(const Unit& u, int r) const { return (unsigned)(u.pm * 256 + r) * 1024u; }
    __device__ __forceinline__ const char* b_base(const Unit& u) const { return (const char*)(Bt + (size_t)u.pn * 256 * 1024); }
};
__device__ __forceinline__ float sigmoidf_(float v) { return __builtin_amdgcn_rcpf(1.f + __builtin_amdgcn_exp2f(-LOG2E * v)); }
__device__ __forceinline__ v4u pack8(const f32x4& v0, const f32x4& v1) { v4u w; w.x = pg8::cvt_pk_bf16(v0[0], v0[1]); w.y = pg8::cvt_pk_bf16(v0[2], v0[3]); w.z = pg8::cvt_pk_bf16(v1[0], v1[1]); w.w = pg8::cvt_pk_bf16(v1[2], v1[3]); return w; }
__device__ __forceinline__ float dot4(const f32x4& v) { return (v[0] * v[0] + v[1] * v[1]) + (v[2] * v[2] + v[3] * v[3]); }

struct EpiInProj {
    bf16* PROJ; bf16* KR; const float* RX; const f32x2* CS; float* SSQ_Q; float* SSQ_KV; LAS float* tl; int pn0; float asc;
    static constexpr bool HAS_PRE = true;
    __device__ __forceinline__ void pre(const Unit& u, int wid, int lane) const {
        if (wid == 7) __builtin_amdgcn_global_load_lds((const unsigned*)(RX + u.pm * 256 + lane * 4), (LAS unsigned*)(tl + (u.ord & 1) * 256), 16, 0, 0); }
    __device__ __forceinline__ void operator()(const f32x4 (&acc)[2][2][4][2], const Unit& u, int wr, int wc, int fr, int fq) const {
        const int pn = u.pn + pn0; const float sc = ((pn == 2 || pn == 3) ? C2D : 1.f) * asc;
#pragma unroll
        for (int ai = 0; ai < 2; ++ai)
#pragma unroll
            for (int m = 0; m < 4; ++m) {
                const int row = u.pm * 256 + ai * HALF + wr * 64 + m * 16 + fr;
                const float rx = tl[(u.ord & 1) * 256 + ai * HALF + wr * 64 + m * 16 + fr] * sc; float ssq = 0.f;
                f32x4 v[2][2];
#pragma unroll
                for (int bj = 0; bj < 2; ++bj) { v[bj][0] = acc[ai][bj][m][0] * rx; v[bj][1] = acc[ai][bj][m][1] * rx; }
                if (pn >= 8) {
#pragma unroll
                    for (int n = 0; n < 2; ++n)
#pragma unroll
                        for (int i = 0; i < 4; ++i) { const float em1 = 1.f + __builtin_amdgcn_exp2f(-LOG2E * v[0][n][i]), ed1 = 1.f + __builtin_amdgcn_exp2f(-LOG2E * v[1][n][i]);
                            v[1][n][i] = __builtin_amdgcn_rcpf(ed1); v[0][n][i] = ed1 * __builtin_amdgcn_rcpf(em1); } }
                if (pn == 0) ssq += (dot4(v[0][0]) + dot4(v[0][1])) + (dot4(v[1][0]) + dot4(v[1][1]));
                if (pn == 1) ssq += dot4(v[0][0]) + dot4(v[0][1]);
                if (pn == 1 && wc == 0) {
                    const f32x4 cs0 = *(const f32x4*)(CS + (size_t)row * 16 + 4 * fq), cs1 = *(const f32x4*)(CS + (size_t)row * 16 + 4 * fq + 2);
                    const float c[4] = {cs0[0], cs0[2], cs1[0], cs1[2]}, s[4] = {cs0[1], cs0[3], cs1[1], cs1[3]};
                    f32x4 o1, o2;
#pragma unroll
                    for (int i = 0; i < 4; ++i) { o1[i] = v[1][0][i] * c[i] - v[1][1][i] * s[i]; o2[i] = v[1][0][i] * s[i] + v[1][1][i] * c[i]; }
                    *(v4u*)(KR + (size_t)row * 32 + 8 * fq) = pack8(o1, o2);
                }
#pragma unroll
                for (int bj = 0; bj < 2; ++bj) *(v4u*)(PROJ + (size_t)row * NPROJ + pn * 256 + bj * HALF + wc * 32 + 8 * fq) = pack8(v[bj][0], v[bj][1]);
                if (pn <= 1) { ssq += __shfl_xor(ssq, 16); ssq += __shfl_xor(ssq, 32); if (fq == 0) *(float*)((char*)SSQ_Q + (size_t)pn * (WS_SSQKV - WS_SSQQ) + ((size_t)row * 4 + wc) * 4) = ssq; }
            }
    }
};

struct ProbQKV {
    const bf16* PROJ; const bf16* WQ; const bf16* WKV; int K, ldb;
    __device__ __forceinline__ const char* a_base() const { return (const char*)PROJ; }
    __device__ __forceinline__ unsigned a_off(const Unit& u, int r) const { return (unsigned)(((u.pm * 256 + r) * NPROJ + (u.e ? 256 : 0)) * 2); }
    __device__ __forceinline__ const char* b_base(const Unit& u) const { return (const char*)WQ + (size_t)u.e * (WS_WKV - WS_WQ) + (size_t)u.pn * (256 * 256 * 2); }
};
struct OrderQKV { int G, c;
    __device__ __forceinline__ bool next(int i, Unit& u) const { const int L = i * G + c; if (L >= 448) return false;
        if (L < 192) { u.e = 0; u.pm = L / 3; u.pn = L % 3; } else { const int l2 = L - 192; u.e = 1; u.pm = l2 >> 2; u.pn = l2 & 3; } u.rt = 0; u.ord = i; return true; } };
struct OrderIn16 { int G, c;
    __device__ __forceinline__ static int cnt(int v) { return v < 64 ? 2 : v < 128 ? 1 : (v < 192 ? 4 : 1); }
    __device__ __forceinline__ static void unit(int v, int i, Unit& u) {
        if (v < 128 && i == 0) { u.pm = v & 63; u.pn = v >> 6; return; }
        const int t = v < 64 ? v : v < 192 ? 64 + 4 * (v - 128) + i : 320 + (v - 192); u.pm = t / 6; u.pn = 2 + t % 6; }
    __device__ __forceinline__ bool next(int i, Unit& u) const { u.e = 0; u.rt = 0; u.ord = i;
        for (int v = c; v < 256; v += G) { const int n = cnt(v); if (i < n) { unit(v, i, u); return true; } i -= n; } return false; } };
struct OrderIn8 { int G, c;
    __device__ __forceinline__ static int cnt(int v) { return v < 64 ? 1 : v < 128 ? 2 : v < 192 ? 0 : 5; }
    __device__ __forceinline__ static int first(int v) { return v < 64 ? v : v < 128 ? 64 + 2 * (v - 64) : 192 + 5 * (v - 192); }
    __device__ __forceinline__ bool next(int i, Unit& u) const { u.e = 0; u.rt = 0; u.ord = i;
        for (int v = c; v < 256; v += G) { const int n = cnt(v); if (i < n) { const int s = first(v) + i; u.pm = s >> 3; u.pn = s & 7; return true; } i -= n; } return false; } };
struct OrderQKV2 { int G, c;
    __device__ __forceinline__ bool next(int i, Unit& u) const { u.rt = 0; u.ord = i;
        for (int v = c; v < 128; v += G) { const int n = v < 64 ? 3 : 4; if (i < n) { u.e = v >> 6; u.pm = v & 63; u.pn = i; return true; } i -= n; } return false; } };
struct EpiQKV {
    bf16* QM; bf16* KN; bf16* VM; const float* SSQ_Q; const float* SSQ_KV; const f32x2* CS;
    __device__ __forceinline__ void operator()(const f32x4 (&acc)[2][2][4][2], const Unit& u, int wr, int wc, int fr, int fq) const {
        const int pn = u.pn;
#pragma unroll
        for (int ai = 0; ai < 2; ++ai)
#pragma unroll
            for (int m = 0; m < 4; ++m) {
                const int row = u.pm * 256 + ai * HALF + wr * 64 + m * 16 + fr;
                const f32x4 pp = *(const f32x4*)((const char*)SSQ_Q + (size_t)u.e * (WS_SSQKV - WS_SSQQ) + (size_t)row * 16);
                const float ss = (pp[0] + pp[1]) + (pp[2] + pp[3]);
                const float rs = u.e ? rsqrtf(ss * (1.f / 128.f) + EPS) : rsqrtf(ss * (1.f / 256.f) + EPS) * C2M;
#pragma unroll
                for (int bj = 0; bj < 2; ++bj) {
                    f32x4 v0 = acc[ai][bj][m][0] * rs, v1 = acc[ai][bj][m][1] * rs;
                    const int n = pn * 256 + bj * HALF + wc * 32 + 8 * fq;
                    if (u.e == 0) {
                        if (pn < 2) { *(v4u*)(QM + (size_t)row * 768 + (n >> 6) * 96 + (n & 63)) = pack8(v0, v1); }
                        else { const int h = 4 * bj + wc;
                            const f32x4 cs0 = *(const f32x4*)(CS + (size_t)row * 16 + 4 * fq), cs1 = *(const f32x4*)(CS + (size_t)row * 16 + 4 * fq + 2);
                            const float c[4] = {cs0[0], cs0[2], cs1[0], cs1[2]}, s[4] = {cs0[1], cs0[3], cs1[1], cs1[3]};
                            f32x4 o1, o2;
#pragma unroll
                            for (int i = 0; i < 4; ++i) { o1[i] = v0[i] * c[i] - v1[i] * s[i]; o2[i] = v0[i] * s[i] + v1[i] * c[i]; }
                            *(v4u*)(QM + (size_t)row * 768 + h * 96 + 64 + 8 * fq) = pack8(o1, o2); }
                    } else {
                        if (pn < 2) *(v4u*)(KN + (size_t)row * 512 + n) = pack8(v0, v1);
                        else *(v4u*)(VM + (size_t)row * 512 + (n - 512)) = pack8(v0, v1);
                    }
                }
            }
    }
};

__device__ __forceinline__ void unpack8(const v4u& g, float (&f)[8]) { f[0] = bf2f(g.x & 0xffffu); f[1] = bf2f(g.x >> 16); f[2] = bf2f(g.y & 0xffffu); f[3] = bf2f(g.y >> 16); f[4] = bf2f(g.z & 0xffffu); f[5] = bf2f(g.z >> 16); f[6] = bf2f(g.w & 0xffffu); f[7] = bf2f(g.w >> 16); }
struct EpiUp { bf16* MG; const bf16* PROJ;
    static constexpr bool HAS_MID = true;
    __device__ __forceinline__ void mid(f32x4 (&acc)[2][2][4][2], const Unit& u, int wr, int wc, int fr, int fq) const {
        int row0 = u.pm * 256 + wr * 64 + fr; asm volatile("" : "+v"(row0));
#pragma unroll
        for (int ai = 0; ai < 2; ++ai)
#pragma unroll
            for (int m = 0; m < 4; ++m) { const int row = row0 + ai * HALF + m * 16;
#pragma unroll
                for (int bj = 0; bj < 2; ++bj) { const int c = (u.pn * 2 + bj) * 256 + wc * 32 + 8 * fq;
                    const v4u ga = *(const v4u*)(PROJ + (size_t)row * NPROJ + 2048 + c);
                    float fa[8]; unpack8(ga, fa);
#pragma unroll
                    for (int i = 0; i < 4; ++i) { acc[ai][bj][m][0][i] *= fa[i]; acc[ai][bj][m][1][i] *= fa[4 + i]; } }
                asm volatile("" : "+v"(acc[ai][0][m][0]), "+v"(acc[ai][0][m][1]), "+v"(acc[ai][1][m][0]), "+v"(acc[ai][1][m][1]) :: "memory"); }
    }
    __device__ __forceinline__ void operator()(const f32x4 (&acc)[2][2][4][2], const Unit& u, int wr, int wc, int fr, int fq) const {
#pragma unroll
        for (int ai = 0; ai < 2; ++ai)
#pragma unroll
            for (int m = 0; m < 4; ++m) { const int row = u.pm * 256 + ai * HALF + wr * 64 + m * 16 + fr;
#pragma unroll
                for (int bj = 0; bj < 2; ++bj) { const int c = u.pn * 256 + bj * HALF + wc * 32 + 8 * fq;
                    const v4u gb = *(const v4u*)(PROJ + (size_t)row * NPROJ + 2048 + 128 + (u.pn * 2 + bj) * 256 + wc * 32 + 8 * fq); float fb[8]; unpack8(gb, fb);
                    f32x4 v0 = acc[ai][bj][m][0], v1 = acc[ai][bj][m][1];
#pragma unroll
                    for (int i = 0; i < 4; ++i) { v0[i] *= fb[i]; v1[i] *= fb[4 + i]; }
                    *(v4u*)(MG + (size_t)row * DM + c) = pack8(v0, v1); } }
    }
};
struct EpiOut { const float* X; bf16* X1; float* SSQ2;
    __device__ __forceinline__ void operator()(const f32x4 (&acc)[2][2][4][2], const Unit& u, int wr, int wc, int fr, int fq) const {
#pragma unroll
        for (int ai = 0; ai < 2; ++ai)
#pragma unroll
            for (int m = 0; m < 4; ++m) { const int row = u.pm * 256 + ai * HALF + wr * 64 + m * 16 + fr; float ssq = 0.f;
#pragma unroll
                for (int bj = 0; bj < 2; ++bj) { const int c = u.pn * 256 + bj * HALF + wc * 32 + 8 * fq;
                    const f32x4 x0 = *(const f32x4*)(X + (size_t)row * DM + c), x1 = *(const f32x4*)(X + (size_t)row * DM + c + 4);
                    const f32x4 v0 = acc[ai][bj][m][0] + x0, v1 = acc[ai][bj][m][1] + x1;
                    ssq += dot4(v0) + dot4(v1);
                    *(v4u*)(X1 + (size_t)row * DM + c) = pack8(v0, v1); }
                ssq += __shfl_xor(ssq, 16); ssq += __shfl_xor(ssq, 32); if (fq == 0) SSQ2[(size_t)row * 16 + u.pn * 4 + wc] = ssq; }
    }
};

struct ExpertTab { LAS int* tab; };
struct OrderExpert { LAS const int* tab; int nN, G, c, base, win;
    __device__ __forceinline__ bool next(int i, Unit& u) const {
        if (i >= win) return false;
        const int x = c & 7; int idx = (base + i) * (G >> 3) + (c >> 3);
#pragma unroll
        for (int j = 0; j < 4; ++j) { const int e = x + 8 * j; const int nt = tab[33 + e] - tab[32 + e]; const int n = nt * nN;
            if (idx < n) { u.e = e; u.rt = idx / nN; u.pn = idx % nN; u.pm = tab[32 + e] + u.rt; u.ord = i; return true; } idx -= n; }
        return false; } };
constexpr int TOKT_OFF = RING_BYTES, TOKT_UNITS = 16;
template <bool LDSTOK> struct ProbExp1 {
    static constexpr bool FP8 = true;
    const unsigned char* XQ; const unsigned char* W1T8; const int* TOKL; LAS const int* tab; LAS const unsigned short* tokT; int K, ldb;
    __device__ __forceinline__ const char* a_base() const { return (const char*)XQ; }
    __device__ __forceinline__ int tok_g(const Unit& u, int r) const { const int slot = u.rt * 256 + r, last = tab[u.e] - 1; return TOKL[u.e * NTOK + (slot < last ? slot : last)]; }
    __device__ __forceinline__ int tok(const Unit& u, int r) const { if constexpr (LDSTOK) return (int)tokT[u.ord * 256 + r]; else return tok_g(u, r); }
    __device__ __forceinline__ unsigned a_off(const Unit& u, int r) const { return (unsigned)tok(u, r) * 1024u; }
    __device__ __forceinline__ const char* b_base(const Unit& u) const { return (const char*)(W1T8 + ((size_t)u.e * 2048 + (size_t)u.pn * 256) * 1024); }
};
__device__ __forceinline__ v4u pair16(const v2u& wa, const v2u& wb) {
    const auto r0 = __builtin_amdgcn_permlane16_swap(wa.x, wb.x, false, false), r1 = __builtin_amdgcn_permlane16_swap(wa.y, wb.y, false, false);
    return (v4u){r0[0], r1[0], r0[1], r1[1]};
}
struct EpiExp1 { unsigned char* HB; const float* B1; LAS float* tl;
    static constexpr bool HAS_PRE = true;
    __device__ __forceinline__ void pre(const Unit& u, int wid, int lane) const {
        if (wid == 7) __builtin_amdgcn_global_load_lds((const unsigned*)(B1 + (size_t)u.e * 2048 + (lane >> 5) * 1024 + u.pn * 128 + (lane & 31) * 4), (LAS unsigned*)(tl + (u.ord & 1) * 256), 16, 0, 0); }
    __device__ __forceinline__ void operator()(const f32x4 (&acc)[2][2][4][2], const Unit& u, int wr, int wc, int fr, int fq) const {
        const int j0 = u.pn * 128 + wc * 32 + 8 * fq;
        LAS const float* bt = tl + (u.ord & 1) * 256 + wc * 32 + 8 * fq;
        const f32x4 bg0 = *(LAS const f32x4*)bt, bg1 = *(LAS const f32x4*)(bt + 4), bl0 = *(LAS const f32x4*)(bt + 128), bl1 = *(LAS const f32x4*)(bt + 132);
        constexpr float RS = 1.0f / W8_SCALE;
#pragma unroll
        for (int ai = 0; ai < 2; ++ai)
#pragma unroll
            for (int mp = 0; mp < 4; mp += 2) { v2u w[2];
#pragma unroll
                for (int mm = 0; mm < 2; ++mm) { const int m = mp + mm;
                    const f32x4 g0 = acc[ai][0][m][0] * RS + bg0, g1 = acc[ai][0][m][1] * RS + bg1, l0 = acc[ai][1][m][0] * RS + bl0, l1 = acc[ai][1][m][1] * RS + bl1;
                    f32x4 o0, o1;
#pragma unroll
                    for (int i = 0; i < 4; ++i) {
                        { const float g = fminf(g0[i], 7.f), l = fminf(fmaxf(l0[i], -7.f), 7.f); o0[i] = g * __builtin_amdgcn_rcpf(1.f + __builtin_amdgcn_exp2f(-1.702f * LOG2E * g)) * __builtin_fmaf(l, H8_SCALE, H8_SCALE); }
                        { const float g = fminf(g1[i], 7.f), l = fminf(fmaxf(l1[i], -7.f), 7.f); o1[i] = g * __builtin_amdgcn_rcpf(1.f + __builtin_amdgcn_exp2f(-1.702f * LOG2E * g)) * __builtin_fmaf(l, H8_SCALE, H8_SCALE); } }
                    w[mm].x = pk4_fp8(o0[0], o0[1], o0[2], o0[3]); w[mm].y = pk4_fp8(o1[0], o1[1], o1[2], o1[3]); }
                const int r = ai * HALF + wr * 64 + (mp + (fq & 1)) * 16 + fr;
                *(v4u*)(HB + (size_t)(u.pm * 256 + r) * 1024 + j0 - 8 * (fq & 1)) = pair16(w[0], w[1]); }
    }
};
struct ProbExp2 { static constexpr bool FP8 = true; const unsigned char* HB; const unsigned char* W2T8; int K, ldb;
    __device__ __forceinline__ const char* a_base() const { return (const char*)HB; }
    __device__ __forceinline__ unsigned a_off(const Unit& u, int r) const { return (unsigned)(u.pm * 256 + r) * 1024u; }
    __device__ __forceinline__ const char* b_base(const Unit& u) const { return (const char*)(W2T8 + ((size_t)u.e * 1024 + (size_t)u.pn * 256) * 1024); }
};
struct EpiExp2 { unsigned char* YB; const float* B2; LAS float* tl;
    static constexpr bool HAS_PRE = true;
    __device__ __forceinline__ void pre(const Unit& u, int wid, int lane) const {
        if (wid == 7) __builtin_amdgcn_global_load_lds((const unsigned*)(B2 + (size_t)u.e * 1024 + u.pn * 256 + lane * 4), (LAS unsigned*)(tl + (u.ord & 1) * 256), 16, 0, 0); }
    __device__ __forceinline__ void operator()(const f32x4 (&acc)[2][2][4][2], const Unit& u, int wr, int wc, int fr, int fq) const {
#pragma unroll
        for (int bj = 0; bj < 2; ++bj) { const int c = u.pn * 256 + bj * HALF + wc * 32 + 8 * fq;
            LAS const float* bt = tl + (u.ord & 1) * 256 + bj * HALF + wc * 32 + 8 * fq;
            const f32x4 b0 = *(LAS const f32x4*)bt * Y8_SCALE, b1 = *(LAS const f32x4*)(bt + 4) * Y8_SCALE;
#pragma unroll
            for (int ai = 0; ai < 2; ++ai)
#pragma unroll
                for (int mp = 0; mp < 4; mp += 2) { v2u w[2];
                    constexpr float RS = Y8_SCALE / (W8_SCALE * H8_SCALE);
#pragma unroll
                    for (int mm = 0; mm < 2; ++mm) { const f32x4 y0 = acc[ai][bj][mp + mm][0] * RS + b0, y1 = acc[ai][bj][mp + mm][1] * RS + b1;
                        w[mm].x = pk4_fp8(y0[0], y0[1], y0[2], y0[3]); w[mm].y = pk4_fp8(y1[0], y1[1], y1[2], y1[3]); }
                    const int r = ai * HALF + wr * 64 + (mp + (fq & 1)) * 16 + fr;
                    *(v4u*)(YB + (size_t)(u.pm * 256 + r) * 1024 + c - 8 * (fq & 1)) = pair16(w[0], w[1]); } }
    }
};
__device__ __forceinline__ void build_expert_tab(const gu32* ctl, LAS int* tab, int tid) {
    if (tid < 64) {
        const int cnt = (tid < NE) ? (int)ctl[CW_GCNT + tid] : 0; const int tiles = (cnt + 255) >> 8;
        int inc = tiles;
#pragma unroll
        for (int o = 1; o < 32; o <<= 1) { const int up = __shfl_up(inc, o); if ((tid & 63) >= o) inc += up; }
        if (tid < NE) { tab[tid] = cnt; tab[32 + tid] = inc - tiles; }
        if (tid == NE - 1) tab[64] = inc; }
    LDS_WAIT(); __syncthreads();
}

namespace att {
using bf16x8 = __attribute__((ext_vector_type(8))) short;
using s16x4 = __attribute__((ext_vector_type(4))) short;
using f32x16 = __attribute__((ext_vector_type(16))) float;
typedef short v4i16_t __attribute__((ext_vector_type(4)));
typedef LAS const char* lds_cptr;
__constant__ unsigned char T5_BUCKET[128] = {0, 1, 2, 3, 4, 5, 6, 7, 8, 9, 10, 11, 12, 13, 14, 15, 16, 16, 16, 17, 17, 18, 18, 18, 19, 19, 19, 20, 20, 20, 20, 21, 21, 21, 21, 22, 22, 22, 22, 22, 23, 23, 23, 23, 23, 23, 24, 24, 24, 24, 24, 24, 25, 25, 25, 25, 25, 25, 25, 26, 26, 26, 26, 26, 26, 26, 26, 27, 27, 27, 27, 27, 27, 27, 27, 27, 27, 28, 28, 28, 28, 28, 28, 28, 28, 28, 28, 29, 29, 29, 29, 29, 29, 29, 29, 29, 29, 29, 29, 30, 30, 30, 30, 30, 30, 30, 30, 30, 30, 30, 30, 30, 30, 31, 31, 31, 31, 31, 31, 31, 31, 31, 31, 31, 31, 31, 31, 31};
constexpr int NS = 5;
constexpr int WSF_OFF = NS * 24576, BIAS_OFF = WSF_OFF + 8 * 256, ATT_LDS = BIAS_OFF + 512;
static_assert(ATT_LDS <= RING_BYTES, "attention LDS");
#define ASBAR() __builtin_amdgcn_sched_barrier(0)
#define AMFMA(a, b, c) __builtin_amdgcn_mfma_f32_32x32x16_bf16(a, b, c, 0, 0, 0)
#define ABAR_L() asm volatile("s_waitcnt lgkmcnt(0)\n\ts_barrier" ::: "memory")
#define ABAR_VL() asm volatile("s_waitcnt vmcnt(0) lgkmcnt(0)\n\ts_barrier" ::: "memory")
__device__ __forceinline__ int crow(int r, int hi) { return (r & 3) + 8 * (r >> 2) + 4 * hi; }
__device__ __forceinline__ void glds16(const void* gsrc, unsigned lds_dst) { unsigned keep;
    asm volatile("s_mov_b32 %0, m0\n\ts_mov_b32 m0, %2\n\ts_nop 0\n\tglobal_load_lds_dwordx4 %1, off\n\ts_mov_b32 m0, %0" : "=&s"(keep) : "v"(gsrc), "s"(lds_dst) : "memory"); }
__device__ __forceinline__ void glds16_s(const char* sbase, unsigned voff, unsigned lds_dst) { unsigned keep;
    asm volatile("s_mov_b32 %0, m0\n\ts_mov_b32 m0, %3\n\ts_nop 0\n\tglobal_load_lds_dwordx4 %1, %2\n\ts_mov_b32 m0, %0" : "=&s"(keep) : "v"(voff), "s"(sbase), "s"(lds_dst) : "memory"); }
__device__ __forceinline__ float max3f(float a, float b, float c) { return __builtin_fmaxf(__builtin_fmaxf(a, b), c); }
__device__ __forceinline__ s16x4 vtr(lds_cptr p) { return __builtin_bit_cast(s16x4, __builtin_amdgcn_ds_read_tr16_b64_v4i16((LAS v4i16_t*)p)); }
typedef float f32x2_t __attribute__((ext_vector_type(2))); typedef __bf16 bf16x2_t __attribute__((ext_vector_type(2)));
__device__ __forceinline__ unsigned cvtpk_s(float lo, float hi) { f32x2_t v = {lo, hi}; bf16x2_t b = __builtin_convertvector(v, bf16x2_t); return __builtin_bit_cast(unsigned, b); }

struct ConvArgs { const float* w1; const float* w2; const float* nf; unsigned char* W1T8; unsigned char* W2T8; int stride; int mode; };
struct ConvState { int next, ne, nr, ce, cr, pending; };
constexpr int CONV_PER_E = 3072, CONV_NITEM = 32 * CONV_PER_E;
__device__ __forceinline__ void conv_issue(const ConvArgs& C, int e, int r, unsigned stage, int lane) {
    const bool is1 = r < 2048; const int r2 = is1 ? r : r - 2048, kb = r2 & 63, nb = r2 >> 6;
    const int pitch = is1 ? 2048 : 1024;
    const int col0 = is1 ? (((nb >> 1) & 1) * 1024 + (nb >> 2) * 128 + (nb & 1) * 64) : 64 * nb;
    const float* src = (is1 ? C.w1 + (size_t)e * 1024 * 2048 : C.w2 + (size_t)e * 1024 * 1024) + (size_t)(16 * kb + (lane >> 4)) * pitch + col0 + 4 * (lane & 15);
#pragma unroll
    for (int q = 0; q < 4; ++q) glds16(src + (size_t)(4 * q) * pitch, (unsigned)__builtin_amdgcn_readfirstlane(stage + q * 1024));
}
__device__ __forceinline__ void conv_finish(const ConvArgs& C, int e, int r, LAS const float* stg, int lane) {
    const bool is1 = r < 2048; const int r2 = is1 ? r : r - 2048, kb = r2 & 63, nb = r2 >> 6, k0 = 16 * kb;
    float v[16];
#ifdef PROBE_ATT_MODE
    if (C.mode == 4) return;
    if (C.mode == 6) {
#pragma unroll
        for (int k = 0; k < 16; ++k) v[k] = (float)(lane + k);
    } else
#endif
    {
#pragma unroll
    for (int k = 0; k < 16; ++k) v[k] = stg[k * 64 + lane];
    }
#ifdef PROBE_ATT_MODE
    if (C.mode == 5) { asm volatile("" :: "v"(v[0]), "v"(v[1]), "v"(v[2]), "v"(v[3]), "v"(v[4]), "v"(v[5]), "v"(v[6]), "v"(v[7]), "v"(v[8]), "v"(v[9]), "v"(v[10]), "v"(v[11]), "v"(v[12]), "v"(v[13]), "v"(v[14]), "v"(v[15])); return; }
#endif
    if (is1) {
        const __attribute__((address_space(4))) float* nfc = (const __attribute__((address_space(4))) float*)(uintptr_t)C.nf + __builtin_amdgcn_readfirstlane(k0);
#pragma unroll
        for (int k = 0; k < 16; ++k) v[k] *= nfc[k] * W8_SCALE;
    } else {
#pragma unroll
        for (int k = 0; k < 16; ++k) v[k] *= W8_SCALE;
    }
    v4u o; o.x = pk4_fp8(v[0], v[1], v[2], v[3]); o.y = pk4_fp8(v[4], v[5], v[6], v[7]); o.z = pk4_fp8(v[8], v[9], v[10], v[11]); o.w = pk4_fp8(v[12], v[13], v[14], v[15]);
    unsigned char* dst = (is1 ? C.W1T8 + ((size_t)e * 2048 + 64 * nb + lane) * 1024 : C.W2T8 + ((size_t)e * 1024 + 64 * nb + lane) * 1024) + k0;
    *(v4u*)dst = o;
}
struct AttnP {
    const bf16* Q; int qp; const bf16* K; int kp; const bf16* K2; int k2p; const bf16* V; int vp; bf16* O; int op;
    const float* rel_bias; int bh;
};

template <int DQK, int DV, bool BIAS>
__device__ __forceinline__ void attn_unit(const AttnP& T, int qb, LAS unsigned char* shm, const ConvArgs& CV, ConvState& cs) {
    constexpr int NKP = DQK / 8, NVP = DV / 8, NP = NKP + NVP, SLOTB = NP * 1024, KS = DQK / 16, DB = DV / 32, VOFF = NKP * 1024;
    static_assert(SLOTB <= 24576, "slot size");
    constexpr float THR = 8.0f;
    int tid = threadIdx.x; asm volatile("" : "+v"(tid));
    const int lane = tid & 63, r32 = lane & 31, hi = lane >> 5; const int wid = __builtin_amdgcn_readfirstlane(tid >> 6);
    const int half = wid >> 2;
    const int q0 = qb * 256, NT = (q0 + 256) / 64;
    const unsigned lds0 = (unsigned)(uintptr_t)shm;
    LAS float* wsf = (LAS float*)(shm + WSF_OFF) + wid * 64;
    LAS float* biasL = (LAS float*)(shm + BIAS_OFF);
    const char* dsb[3]; unsigned dvo[3]; int dstride[3];
#pragma unroll
    for (int pi_ = 0; pi_ < 3; ++pi_) { const int p_ = wid + 8 * pi_; dsb[pi_] = (const char*)T.K; dvo[pi_] = 0u; dstride[pi_] = 0;
        if (p_ < NKP) { if (DQK == 96 && p_ >= 8) { dsb[pi_] = (const char*)(T.K2 + (p_ - 8) * 8); dvo[pi_] = (unsigned)(lane * T.k2p) * 2u; dstride[pi_] = 128 * T.k2p; } else { dsb[pi_] = (const char*)(T.K + p_ * 8); dvo[pi_] = (unsigned)(lane * T.kp) * 2u; dstride[pi_] = 128 * T.kp; } }
        else if (p_ < NP) { const int pv_ = p_ - NKP; dsb[pi_] = (const char*)(T.V + (size_t)(16 * (pv_ & 3)) * T.vp + (pv_ >> 2) * 32); dvo[pi_] = (unsigned)((lane >> 2) * T.vp + (lane & 3) * 8) * 2u; dstride[pi_] = 128 * T.vp; }
        asm volatile("" : "+v"(dvo[pi_])); }
    const unsigned ddst0 = lds0 + wid * 1024;
#define DMA_NEXT(slotoff) do { _Pragma("unroll") for (int pi_ = 0; pi_ < 3; ++pi_) { if (pi_ < 2 || NP == 24 || wid < NP - 16) { \
        glds16_s(dsb[pi_], dvo[pi_], (unsigned)__builtin_amdgcn_readfirstlane(ddst0 + (slotoff) + pi_ * 8192)); dsb[pi_] += dstride[pi_]; } } } while (0)
    DMA_NEXT(0); DMA_NEXT(SLOTB); DMA_NEXT(2 * SLOTB);
    bf16x8 qr[KS];
    { const bf16* Qw = T.Q + (size_t)(q0 + wid * 32 + r32) * T.qp + hi * 8;
#pragma unroll
      for (int ks = 0; ks < KS; ++ks) qr[ks] = *reinterpret_cast<const bf16x8*>(Qw + ks * 16);
#pragma unroll
      for (int ks = 0; ks < KS; ++ks) asm volatile("" : "+v"(qr[ks])); }
    if (BIAS) { if (tid < 128) { const float b31 = T.rel_bias[31 * 4 + T.bh]; biasL[tid] = (T.rel_bias[(int)T5_BUCKET[tid] * 4 + T.bh] - b31) * LOG2E; } }
    float mhat = 0.f, l_reg = 0.f;
    f32x16 o[DB];
#pragma unroll
    for (int d = 0; d < DB; ++d) o[d] = f32x16{};
    f32x16 negm = f32x16{}; asm volatile("" : "+v"(negm));
    typedef unsigned u32x4 __attribute__((ext_vector_type(4)));
    u32x4 pw0 = {0u, 0u, 0u, 0u}, pw1 = pw0, pw2 = pw0, pw3 = pw0;
    const int qrel = wid * 32 + r32;
    const lds_cptr shm3 = (lds_cptr)shm;
    const lds_cptr kp0 = shm3 + hi * 1024 + r32 * 16;
    const lds_cptr vp0 = shm3 + VOFF + ((lane >> 4) & 1) * 32 + (lane & 3) * 8 + (4 * hi + ((lane & 15) >> 2)) * 64;
    ABAR_VL();
    bf16x8 kf[2 * KS];
#define KLOAD(slotoff) do { const lds_cptr kb_ = kp0 + (slotoff); _Pragma("unroll") for (int ks = 0; ks < KS; ++ks) { kf[2 * ks] = *(const LAS bf16x8*)(kb_ + ks * 2048); kf[2 * ks + 1] = *(const LAS bf16x8*)(kb_ + ks * 2048 + 512); } } while (0)
    KLOAD(0);
    if (half == 1) ABAR_L();
    s16x4 vl[2][4], vh[2][4];
#define VRD(buf, d0, slotoff) do { const lds_cptr vp_ = vp0 + (slotoff) + (d0) * 4096; _Pragma("unroll") for (int ks = 0; ks < 4; ++ks) { vl[buf][ks] = vtr(vp_ + ks * 1024); vh[buf][ks] = vtr(vp_ + ks * 1024 + 512); } } while (0)
#define VFR(buf, k) ((bf16x8){vl[buf][k][0], vl[buf][k][1], vl[buf][k][2], vl[buf][k][3], vh[buf][k][0], vh[buf][k][1], vh[buf][k][2], vh[buf][k][3]})
#define PV_BLK(buf, d0) do { o[d0] = AMFMA(__builtin_bit_cast(bf16x8, pw0), VFR(buf, 0), o[d0]); o[d0] = AMFMA(__builtin_bit_cast(bf16x8, pw1), VFR(buf, 1), o[d0]); \
        o[d0] = AMFMA(__builtin_bit_cast(bf16x8, pw2), VFR(buf, 2), o[d0]); o[d0] = AMFMA(__builtin_bit_cast(bf16x8, pw3), VFR(buf, 3), o[d0]); } while (0)
#define SGB_MFMA_DS(nm, nd) do { __builtin_amdgcn_sched_group_barrier(0x8, nm, 0); __builtin_amdgcn_sched_group_barrier(0x100, nd, 0); } while (0)
#define PV_ALL(slotoff) do { _Pragma("unroll") for (int d0 = 0; d0 < DB; ++d0) { if (d0 + 1 < DB) VRD((d0 + 1) & 1, d0 + 1, slotoff); PV_BLK(d0 & 1, d0); \
        if (d0 + 1 < DB) { SGB_MFMA_DS(1, 2); SGB_MFMA_DS(1, 2); SGB_MFMA_DS(1, 2); SGB_MFMA_DS(1, 2); } ASBAR(); } } while (0)
    int sl_prev = 4 * SLOTB, slot_t = 0, sl_d = 3 * SLOTB;
    for (int t = 0; t < NT; ++t) {
        ASBAR();
        __builtin_amdgcn_s_setprio(1);
        const bool more = (t + 3 < NT);
        f32x16 s0, s1;
#define QK_ALL() do { _Pragma("unroll") for (int ks = 0; ks < KS; ++ks) { \
            if (ks == 0) { s0 = AMFMA(kf[0], qr[0], negm); s1 = AMFMA(kf[1], qr[0], negm); } \
            else { s0 = AMFMA(kf[2 * ks], qr[ks], s0); s1 = AMFMA(kf[2 * ks + 1], qr[ks], s1); } } } while (0)
        if (t > 0) {
            VRD(0, 0, sl_prev); QK_ALL();
            SGB_MFMA_DS(1, 1); SGB_MFMA_DS(1, 1); SGB_MFMA_DS(1, 1); SGB_MFMA_DS(1, 1); SGB_MFMA_DS(1, 1); SGB_MFMA_DS(1, 1); SGB_MFMA_DS(1, 1); SGB_MFMA_DS(1, 1);
            __builtin_amdgcn_sched_group_barrier(0x8, 2 * KS - 8, 0);
        } else { QK_ALL(); }
#undef QK_ALL
        ASBAR();
        if (more) DMA_NEXT(sl_d);
        ASBAR();
        if (t > 0) PV_ALL(sl_prev);
        __builtin_amdgcn_s_setprio(0);
#if defined(ATT_NOP_M)
        asm volatile("s_nop 15\n\ts_nop 15\n\ts_nop 15\n\ts_nop 15\n\ts_nop 15\n\ts_nop 15\n\ts_nop 15\n\ts_nop 15\n\ts_nop 15\n\ts_nop 15\n\ts_nop 15\n\ts_nop 15\n\ts_nop 15\n\ts_nop 15\n\ts_nop 15\n\ts_nop 15" ::: "memory");
#endif
        ASBAR();
        if (more) { if (NP == 24 || wid < (NP - 16)) asm volatile("s_waitcnt vmcnt(3) lgkmcnt(0)\n\ts_barrier" ::: "memory"); else asm volatile("s_waitcnt vmcnt(2) lgkmcnt(0)\n\ts_barrier" ::: "memory"); }
        else ABAR_VL();
        ASBAR();
        { const int jb = t - (NT - 4);
          if (jb >= 0) { const int kb_ = 64 * jb + 4 * hi;
#pragma unroll
              for (int r = 0; r < 16; ++r) { const int kv = kb_ + (r & 3) + 8 * (r >> 2); if (kv > qrel) s0[r] = -INFINITY; if (kv + 32 > qrel) s1[r] = -INFINITY; } }
          if (BIAS) { if (q0 + wid * 32 - (64 * t + 63) < 113) {
              const int db = q0 + qrel - 64 * t - 4 * hi;
#pragma unroll
              for (int r = 0; r < 16; ++r) { int d0_ = db - ((r & 3) + 8 * (r >> 2)); int d1_ = d0_ - 32;
                  d0_ = d0_ < 0 ? 0 : (d0_ > 127 ? 127 : d0_); d1_ = d1_ < 0 ? 0 : (d1_ > 127 ? 127 : d1_);
                  s0[r] += biasL[d0_]; s1[r] += biasL[d1_]; } } }
          float a_ = max3f(s0[0], s0[1], s1[0]), b_ = max3f(s0[2], s0[3], s1[1]); a_ = max3f(a_, s1[2], s1[3]);
#pragma unroll
          for (int r = 4; r < 16; r += 4) { a_ = max3f(a_, s0[r], s0[r + 1]); b_ = max3f(b_, s0[r + 2], s0[r + 3]); a_ = max3f(a_, s1[r], s1[r + 1]); b_ = max3f(b_, s1[r + 2], s1[r + 3]); }
          float rm = __builtin_fmaxf(a_, b_);
          { auto rr = __builtin_amdgcn_permlane32_swap(__float_as_uint(rm), __float_as_uint(rm), false, false); rm = __builtin_fmaxf(__uint_as_float(rr[0]), __uint_as_float(rr[1])); }
          if (t == 0 || __any(rm > THR)) {
              const float dl = (t == 0) ? rm : __builtin_fmaxf(rm, 0.f);
              mhat += dl;
#pragma unroll
              for (int r = 0; r < 16; ++r) { s0[r] -= dl; s1[r] -= dl; }
#pragma unroll
              for (int r = 0; r < 16; ++r) negm[r] = -mhat;
              asm volatile("" : "+v"(negm));
              if (t > 0) { const float f = __builtin_amdgcn_exp2f(-dl); l_reg *= f; if (hi == 0) wsf[r32] = f;
                  LDS_WAIT();
                  float fr_[16];
#pragma unroll
                  for (int r = 0; r < 16; ++r) fr_[r] = wsf[crow(r, hi)];
#pragma unroll
                  for (int d = 0; d < DB; ++d)
#pragma unroll
                      for (int r = 0; r < 16; ++r) o[d][r] *= fr_[r];
              }
          }
#if defined(ATT_DUP_V)
          { float sa_ = 0.f;
#pragma unroll
            for (int r = 0; r < 16; ++r) { float x_ = s0[r], y_ = s1[r]; asm volatile("" : "+v"(x_), "+v"(y_)); x_ = __builtin_amdgcn_exp2f(x_); y_ = __builtin_amdgcn_exp2f(y_); sa_ += x_ + y_; unsigned w_ = cvtpk_s(x_, y_); asm volatile("" :: "v"(w_)); }
            asm volatile("" :: "v"(sa_)); }
#endif
#pragma unroll
          for (int r = 0; r < 16; ++r) { s0[r] = __builtin_amdgcn_exp2f(s0[r]); s1[r] = __builtin_amdgcn_exp2f(s1[r]); }
          { float one_ = 1.0f; asm volatile("" : "+v"(one_)); float a0_ = 0.f, a1_ = 0.f;
#pragma unroll
            for (int r = 0; r < 16; ++r) { a0_ = a0_ + s0[r]; a1_ = __builtin_fmaf(s1[r], one_, a1_); }
            l_reg += a0_ + a1_; }
          pw0 = (u32x4){cvtpk_s(s0[0], s0[1]), cvtpk_s(s0[2], s0[3]), cvtpk_s(s0[4], s0[5]), cvtpk_s(s0[6], s0[7])};
          pw1 = (u32x4){cvtpk_s(s0[8], s0[9]), cvtpk_s(s0[10], s0[11]), cvtpk_s(s0[12], s0[13]), cvtpk_s(s0[14], s0[15])};
          pw2 = (u32x4){cvtpk_s(s1[0], s1[1]), cvtpk_s(s1[2], s1[3]), cvtpk_s(s1[4], s1[5]), cvtpk_s(s1[6], s1[7])};
          pw3 = (u32x4){cvtpk_s(s1[8], s1[9]), cvtpk_s(s1[10], s1[11]), cvtpk_s(s1[12], s1[13]), cvtpk_s(s1[14], s1[15])};
        }
        if (t + 1 < NT) KLOAD((slot_t == 4 * SLOTB) ? 0 : slot_t + SLOTB);
        if ((t & 3) == 0) {
            LAS const float* stg_ = (LAS const float*)(shm + CONV_OFF + wid * 4096);
            if (cs.pending) { conv_finish(CV, cs.ce, cs.cr, stg_, lane); cs.pending = 0; }
            if (cs.next < CONV_NITEM) { LDS_WAIT(); conv_issue(CV, cs.ne, cs.nr, lds0 + CONV_OFF + wid * 4096, lane); cs.ce = cs.ne; cs.cr = cs.nr; cs.pending = 1;
                cs.next += CV.stride; cs.nr += CV.stride; while (cs.nr >= CONV_PER_E) { cs.nr -= CONV_PER_E; ++cs.ne; } }
        }
#if defined(ATT_NOP_V)
        asm volatile("s_nop 15\n\ts_nop 15\n\ts_nop 15\n\ts_nop 15\n\ts_nop 15\n\ts_nop 15\n\ts_nop 15\n\ts_nop 15\n\ts_nop 15\n\ts_nop 15\n\ts_nop 15\n\ts_nop 15\n\ts_nop 15\n\ts_nop 15\n\ts_nop 15\n\ts_nop 15" ::: "memory");
#endif
        ASBAR();
        ABAR_L();
        ASBAR();
        sl_prev = slot_t; slot_t = (slot_t == 4 * SLOTB) ? 0 : slot_t + SLOTB; sl_d = (sl_d == 4 * SLOTB) ? 0 : sl_d + SLOTB;
    }
    if (half == 0) ABAR_L();
    VRD(0, 0, sl_prev); PV_ALL(sl_prev);
    { auto rr = __builtin_amdgcn_permlane32_swap(__float_as_uint(l_reg), __float_as_uint(l_reg), false, false); l_reg = __uint_as_float(rr[0]) + __uint_as_float(rr[1]); }
    if (hi == 0) wsf[32 + r32] = l_reg;
    LDS_WAIT();
    { const int kbusy = sl_prev / SLOTB, pr = wid >> 1, fs = pr + (pr >= kbusy ? 1 : 0);
      LAS unsigned short* stg = (LAS unsigned short*)(shm + fs * SLOTB + (wid & 1) * (32 * DV * 2));
#pragma unroll
      for (int r = 0; r < 16; ++r) { const int orow = crow(r, hi); const float rl = __builtin_amdgcn_rcpf(wsf[32 + orow]);
#pragma unroll
          for (int d = 0; d < DB; ++d) stg[orow * DV + d * 32 + r32] = (unsigned short)f2bf(o[d][r] * rl); }
      LDS_WAIT();
      bf16* Ow = T.O + (size_t)(q0 + wid * 32) * T.op;
      constexpr int CPR = DV / 8, RPI = 64 / CPR;
#pragma unroll
      for (int i = 0; i < 32 / RPI; ++i) { const int row = i * RPI + lane / CPR, ch = lane % CPR;
          const v4u v = *(const LAS v4u*)(stg + row * DV + ch * 8); *(v4u*)(Ow + (size_t)row * T.op + ch * 8) = v; } }
    ABAR_L();
#undef DMA_NEXT
#undef PV_ALL
#undef SGB_MFMA_DS
#undef PV_BLK
#undef VFR
#undef VRD
#undef KLOAD
}
#undef ASBAR
#undef AMFMA
#undef ABAR_L
#undef ABAR_VL
}

__device__ __forceinline__ void p4_combine(const Args& a, int vcu, int G) {
    int tid_ = threadIdx.x; asm volatile("" : "+v"(tid_)); const int lane = tid_ & 63, wave = __builtin_amdgcn_readfirstlane(tid_ >> 6);
    const bf16* OD = (const bf16*)(a.ws + WS_OD); bf16* YC = (bf16*)(a.ws + WS_YC);
    float s1 = a.diff_lambda[lane] * a.diff_lambda[64 + lane], s2 = a.diff_lambda[128 + lane] * a.diff_lambda[192 + lane];
    s1 = wave_sum(s1); s2 = wave_sum(s2);
    const float lam = expf(s1) - expf(s2) + 0.2f;
    const int gw = vcu * NWAVES + wave, NGW = G * NWAVES, sub = lane >> 4, l16 = lane & 15;
    for (int it0 = gw * 4 + sub; it0 < NTOK * 4; it0 += 16 * NGW) {
        v4u w0[4], w1[4];
#pragma unroll
        for (int q = 0; q < 4; ++q) { const int it = it0 + q * 4 * NGW; if (it < NTOK * 4) { const int row = it >> 2, h = it & 3;
            w0[q] = *(const v4u*)(OD + (size_t)row * 1024 + (2 * h) * 128 + 8 * l16); w1[q] = *(const v4u*)(OD + (size_t)row * 1024 + (2 * h + 1) * 128 + 8 * l16); } else { w0[q] = (v4u){0u, 0u, 0u, 0u}; w1[q] = w0[q]; } }
#pragma unroll
        for (int q = 0; q < 4; ++q) { const int it = it0 + q * 4 * NGW; const int row = it >> 2, h = it & 3;
            float fa[8], fb[8]; unpack8(w0[q], fa); unpack8(w1[q], fb);
            f32x4 y0, y1; float ss = 0.f;
#pragma unroll
            for (int k = 0; k < 4; ++k) { y0[k] = fa[k] - lam * fb[k]; y1[k] = fa[4 + k] - lam * fb[4 + k]; ss += y0[k] * y0[k] + y1[k] * y1[k]; }
            ss += __shfl_xor(ss, 1); ss += __shfl_xor(ss, 2); ss += __shfl_xor(ss, 4); ss += __shfl_xor(ss, 8);
            const float r = rsqrtf(ss * (1.f / 128.f) + EPS);
            if (it < NTOK * 4) *(v4u*)(YC + (size_t)row * 1024 + 512 + h * 128 + 8 * l16) = pack8(y0 * r, y1 * r); }
    }
}

__device__ __forceinline__ void p7_router(const Args& a, LAS unsigned char* lds, int vcu, int G) {
    int tid = threadIdx.x; asm volatile("" : "+v"(tid)); const int lane = tid & 63, wave = __builtin_amdgcn_readfirstlane(tid >> 6);
    typedef float f32x16 __attribute__((ext_vector_type(16)));
    const bf16* X1 = (const bf16*)(a.ws + WS_X1); const float* WRT = (const float*)(a.ws + WS_WR); const float* SSQ2 = (const float*)(a.ws + WS_SSQ2);
    int* TOKL = (int*)(a.ws + WS_TOKL); int* SEL = (int*)(a.ws + WS_SEL); float* WTS = (float*)(a.ws + WS_WTS);
    gu32* ctl = (gu32*)(a.ws + WS_CTL); unsigned char* XQ = a.ws + WS_XQ;
    LAS float* xs = (LAS float*)(lds + RING_OFF) + wave * (32 * 65);
    LAS float* part = (LAS float*)(lds + RING_OFF + 8 * 32 * 65 * 4);
    LAS int* lcnt = (LAS int*)(lds + RING_OFF + 8 * 32 * 65 * 4 + 8 * 32 * 33 * 4);
    LAS float* r2s = (LAS float*)(lcnt + 64);
    for (int blk = vcu; blk < NTOK / 64; blk += G) {
        const int tok0 = blk * 64;
        const int grp = wave >> 2, kq = wave & 3, i = lane & 31, h = lane >> 5;
        if (tid < 64) { const int t = tok0 + tid; float ss = 0.f;
#pragma unroll
            for (int j = 0; j < 4; ++j) { const f32x4 p = *(const f32x4*)(SSQ2 + (size_t)t * 16 + 4 * j); ss += (p[0] + p[1]) + (p[2] + p[3]); }
            r2s[tid] = rsqrtf(ss * (1.f / DM) + EPS); }
        LDS_WAIT(); __syncthreads();
        f32x16 acc = f32x16{};
        const bf16* xg = X1 + (size_t)(tok0 + grp * 32 + (lane >> 3)) * DM + kq * 256 + 8 * (lane & 7);
        const float* wg = WRT + (size_t)i * DM + kq * 256 + 4 * h;
        v4u xq[4]; f32x4 wv[8];
#pragma unroll
        for (int j = 0; j < 4; ++j) xq[j] = *(const v4u*)(xg + (size_t)(8 * j) * DM);
#pragma unroll
        for (int c = 0; c < 8; ++c) wv[c] = *(const f32x4*)(wg + 8 * c);
#pragma unroll
        for (int p = 0; p < 4; ++p) {
            v4u xn[4]; f32x4 wn[8];
            if (p < 3) {
#pragma unroll
                for (int j = 0; j < 4; ++j) xn[j] = *(const v4u*)(xg + (size_t)(8 * j) * DM + 64 * (p + 1));
#pragma unroll
                for (int c = 0; c < 8; ++c) wn[c] = *(const f32x4*)(wg + 64 * (p + 1) + 8 * c); }
#pragma unroll
            for (int j = 0; j < 4; ++j) { float xv[8]; unpack8(xq[j], xv);
                LAS float* d = xs + ((lane >> 3) + 8 * j) * 65 + 8 * (lane & 7);
#pragma unroll
                for (int i2 = 0; i2 < 8; ++i2) d[i2] = xv[i2];
                const int tl = grp * 32 + (lane >> 3) + 8 * j; const float rr = r2s[tl];
                v2u o8; o8.x = pk4_fp8(xv[0] * rr, xv[1] * rr, xv[2] * rr, xv[3] * rr); o8.y = pk4_fp8(xv[4] * rr, xv[5] * rr, xv[6] * rr, xv[7] * rr);
                *(v2u*)(XQ + (size_t)(tok0 + tl) * 1024 + kq * 256 + 64 * p + 8 * (lane & 7)) = o8; }
            LDS_WAIT();
#pragma unroll
            for (int c = 0; c < 8; ++c)
#pragma unroll
                for (int q = 0; q < 4; ++q) acc = __builtin_amdgcn_mfma_f32_32x32x2f32(xs[i * 65 + 8 * c + 4 * h + q], wv[c][q], acc, 0, 0, 0);
            LDS_WAIT();
            if (p < 3) {
#pragma unroll
                for (int j = 0; j < 4; ++j) xq[j] = xn[j];
#pragma unroll
                for (int c = 0; c < 8; ++c) wv[c] = wn[c]; }
        }
        if (tid < 32) lcnt[tid] = 0;
#pragma unroll
        for (int r = 0; r < 16; ++r) part[(wave * 32 + ((r & 3) + 8 * (r >> 2) + 4 * h)) * 33 + i] = acc[r];
        LDS_WAIT(); __syncthreads();
        if (tid < 64) {
            const int t = tok0 + tid, g2 = tid >> 5, ti = tid & 31;
            const float r2 = r2s[tid];
            float lg[NE];
#pragma unroll
            for (int e = 0; e < NE; ++e) { float s = 0.f;
#pragma unroll
                for (int k4 = 0; k4 < 4; ++k4) s += part[((g2 * 4 + k4) * 32 + ti) * 33 + e];
                lg[e] = s * r2 + a.b_router[e]; }
            float tv[4]; int te[4];
#pragma unroll
            for (int r = 0; r < 4; ++r) { float best = -3.0e38f; int bi = 0;
#pragma unroll
                for (int e = 0; e < NE; ++e) { if (lg[e] > best) { best = lg[e]; bi = e; } }
                tv[r] = best; te[r] = bi;
#pragma unroll
                for (int e = 0; e < NE; ++e) if (e == bi) lg[e] = -3.0e38f; }
            float ev[4], sum = 0.f;
#pragma unroll
            for (int r = 0; r < 4; ++r) { ev[r] = __expf(tv[r] - tv[0]); sum += ev[r]; }
            const float rs = 1.f / sum;
            int ls[4];
#pragma unroll
            for (int r = 0; r < 4; ++r) { ls[r] = __hip_atomic_fetch_add(lcnt + te[r], 1, __ATOMIC_RELAXED, __HIP_MEMORY_SCOPE_WORKGROUP); WTS[t * 4 + r] = ev[r] * rs; }
            LDS_WAIT();
            __builtin_amdgcn_wave_barrier();
            if (tid < 32) { const int n = lcnt[tid]; lcnt[32 + tid] = n ? (int)__hip_atomic_fetch_add(ctl + CW_GCNT + tid, (unsigned)n, RLX_AGENT) : 0; }
            LDS_WAIT();
            __builtin_amdgcn_wave_barrier();
#pragma unroll
            for (int r = 0; r < 4; ++r) { const int slot = lcnt[32 + te[r]] + ls[r]; TOKL[te[r] * NTOK + slot] = t; SEL[t * 4 + r] = (te[r] << 16) | slot; }
        }
        LDS_WAIT(); __syncthreads();
    }
}

__device__ __forceinline__ void p10_final(const Args& a, LAS int* tab, int vcu, int G) {
    int tid_ = threadIdx.x; asm volatile("" : "+v"(tid_)); const int lane = tid_ & 63, wave = __builtin_amdgcn_readfirstlane(tid_ >> 6);
    const bf16* X1 = (const bf16*)(a.ws + WS_X1); const unsigned char* YB = a.ws + WS_YB; const int* SEL = (const int*)(a.ws + WS_SEL); const float* WTS = (const float*)(a.ws + WS_WTS);
    const int gw = vcu * NWAVES + wave, NGW = G * NWAVES;
    for (int t0 = gw; t0 < NTOK; t0 += 2 * NGW) {
        int sel[2][4]; float wt[2][4]; int tq[2];
#pragma unroll
        for (int q = 0; q < 2; ++q) { tq[q] = (t0 + q * NGW < NTOK) ? t0 + q * NGW : t0;
#pragma unroll
            for (int k = 0; k < 4; ++k) { sel[q][k] = SEL[tq[q] * 4 + k]; wt[q][k] = WTS[tq[q] * 4 + k] * (1.0f / Y8_SCALE); } }
        f32x4 v[2][4]; int yv[2][4][4];
#pragma unroll
        for (int q = 0; q < 2; ++q) { const GAS v2u* xr = (const GAS v2u*)(X1 + (size_t)tq[q] * DM) + lane;
#pragma unroll
            for (int j = 0; j < 4; ++j) { const v2u x2 = xr[64 * j]; v[q][j] = (f32x4){bf2f(x2.x & 0xffffu), bf2f(x2.x >> 16), bf2f(x2.y & 0xffffu), bf2f(x2.y >> 16)}; }
#pragma unroll
            for (int k = 0; k < 4; ++k) { const int e = sel[q][k] >> 16, slot = sel[q][k] & 0xffff;
                const size_t hrow = (size_t)tab[32 + e] * 256 + slot;
                const GAS int* yr = (const GAS int*)(YB + hrow * 1024) + lane;
#pragma unroll
                for (int j = 0; j < 4; ++j) yv[q][k][j] = yr[64 * j]; } }
#pragma unroll
        for (int q = 0; q < 2; ++q) {
#pragma unroll
            for (int k = 0; k < 4; ++k) { const float w = wt[q][k];
#pragma unroll
                for (int j = 0; j < 4; ++j) { const int y = yv[q][k][j];
                    const f32x2 lo = __builtin_amdgcn_cvt_pk_f32_fp8(y, false), hi = __builtin_amdgcn_cvt_pk_f32_fp8(y, true);
                    v[q][j].x += w * lo[0]; v[q][j].y += w * lo[1]; v[q][j].z += w * hi[0]; v[q][j].w += w * hi[1]; } }
            float s = 0.f;
#pragma unroll
            for (int j = 0; j < 4; ++j) s += (v[q][j].x * v[q][j].x + v[q][j].y * v[q][j].y) + (v[q][j].z * v[q][j].z + v[q][j].w * v[q][j].w);
            s = wave_sum(s);
            const float r = rsqrtf(s * (1.f / DM) + EPS);
            if (q == 0 || t0 + NGW < NTOK) { GAS f32x4* orow = (GAS f32x4*)(a.out + (size_t)tq[q] * DM) + lane;
#pragma unroll
                for (int j = 0; j < 4; ++j) { const f32x4 g = *((const GAS f32x4*)a.norm_final + lane + 64 * j); orow[64 * j] = v[q][j] * r * g; } } }
    }
}

constexpr int N_PHASES = 11;
__global__ void __launch_bounds__(NWAVES * 64, 2) mk_fwd(Args args) {
    extern __shared__ __attribute__((aligned(16))) unsigned char lds_raw[];
    LAS unsigned char* lds = (LAS unsigned char*)lds_raw;
    volatile LAS unsigned* MISC = (volatile LAS unsigned*)(lds + MISC_OFF);
    LAS int* tab = (LAS int*)(lds + TAB_OFF);
    const int tid = threadIdx.x;
    const int G = gridDim.x; const int bx = blockIdx.x; const int vcu = (G % 8 == 0) ? (bx % 8) * (G / 8) + bx / 8 : bx;
    unsigned char* ws = args.ws;
    gu32* ctl = (gu32*)(ws + WS_CTL);
    for (int u = tid; u < (LDS_BYTES - LDSCTL_OFF) / 4; u += NWAVES * 64) ((LAS unsigned*)(lds + LDSCTL_OFF))[u] = 0u;
    __syncthreads();
    const int lo = args.ph_lo, hi = args.ph_hi;
    const bool multi = (hi - lo) > 1;
    XcdBarrier bar; bar.bar = (unsigned*)(ctl + CW_BAR); bar.x = 0; bar.st = nullptr;
    if (multi) bar = xcd_barrier_post((unsigned*)(ctl + CW_BAR), MISC + 8);
#ifndef MK_ONLY
#define MK_ONLY (-1)
#endif
#define IN(k) ((MK_ONLY < 0 || MK_ONLY == (k)) && lo <= (k) && (k) < hi)
#define BOTH(k) (IN(k) && IN((k) + 1))
#ifdef MK_XBAR
#define SEAM(k) do { if (BOTH(k)) { xcd_barrier(bar); xcd_barrier(bar); } } while (0)
#else
#define SEAM(k) do { if (BOTH(k)) xcd_barrier(bar); } while (0)
#endif

    bf16* PROJ = (bf16*)(ws + WS_PROJ);
#ifndef MK_REPEAT
#define MK_REPEAT 0
#endif
#define RUN(k, ...) do { if (IN(k)) { __VA_ARGS__ if constexpr ((MK_REPEAT >> (k)) & 1) { xcd_barrier(bar); __VA_ARGS__ } SEAM(k); } } while (0)
    RUN(0, { p0_prologue(args, lds, vcu, G); });
    RUN(1, {
        { ProbPlain P{(const bf16*)(ws + WS_XB), (const bf16*)(ws + WS_WIN), DM, DM, 0, 0, DM};
          OrderIn16 S{G, vcu};
          EpiInProj E{PROJ, (bf16*)(ws + WS_KR), (const float*)(ws + WS_RX), (const f32x2*)(ws + WS_CS), (float*)(ws + WS_SSQQ), (float*)(ws + WS_SSQKV), (LAS float*)(lds + EPI_TAB_OFF), 0, 1.f};
          pg8::gemm_phase(lds + RING_OFF, P, S, E);
#ifdef PROBE_CALL1
          xcd_barrier(bar); pg8::gemm_phase(lds + RING_OFF, P, S, E); xcd_barrier(bar);
#endif
        }
        { ProbPlain8 P{ws + WS_XB8, ws + WS_WING8, 512, 512};
          OrderIn8 S{G, vcu};
          EpiInProj E{PROJ, (bf16*)(ws + WS_KR), (const float*)(ws + WS_RX), (const f32x2*)(ws + WS_CS), (float*)(ws + WS_SSQQ), (float*)(ws + WS_SSQKV), (LAS float*)(lds + EPI_TAB_OFF), 8, 1.f / (X8_SCALE * W8_SCALE)};
          pg8::gemm_phase(lds + RING_OFF, P, S, E);
#ifdef PROBE_CALL2
          xcd_barrier(bar); pg8::gemm_phase(lds + RING_OFF, P, S, E); xcd_barrier(bar);
#endif
        }
        { ProbQKV P{PROJ, (const bf16*)(ws + WS_WQ), (const bf16*)(ws + WS_WKV), 256, 256};
          OrderQKV2 S{G, vcu};
          EpiQKV E{(bf16*)(ws + WS_QM), (bf16*)(ws + WS_KN), (bf16*)(ws + WS_VM), (const float*)(ws + WS_SSQQ), (const float*)(ws + WS_SSQKV), (const f32x2*)(ws + WS_CS)};
          pg8::gemm_phase(lds + RING_OFF, P, S, E);
#ifdef PROBE_CALL3
          xcd_barrier(bar); pg8::gemm_phase(lds + RING_OFF, P, S, E); xcd_barrier(bar);
#endif
        } });
    RUN(3, {
        int tid3 = threadIdx.x; asm volatile("" : "+v"(tid3)); const int wave3 = __builtin_amdgcn_readfirstlane(tid3 >> 6), lane3 = tid3 & 63;
        const att::ConvArgs CV{args.w1, args.w2, args.norm_ffn, ws + WS_W1T, ws + WS_W2T, G * NWAVES, 0};
        att::ConvState cs{vcu * NWAVES + wave3, (vcu * NWAVES + wave3) / att::CONV_PER_E, (vcu * NWAVES + wave3) % att::CONV_PER_E, 0, 0, 0};
        for (int p = vcu; p < 512; p += G) {
            const int type = p >> 8, pp = p & 255, hd = pp >> 4, s = pp & 15, b = hd >> 3, hh = hd & 7;
            const size_t r0 = (size_t)b * SEQ;
            if (type == 0) {
                att::AttnP T{(const bf16*)(ws + WS_QM) + r0 * 768 + hh * 96, 768, (const bf16*)(ws + WS_KN) + r0 * 512 + hh * 64, 512, (const bf16*)(ws + WS_KR) + r0 * 32, 32,
                             (const bf16*)(ws + WS_VM) + r0 * 512 + hh * 64, 512, (bf16*)(ws + WS_YC) + r0 * 1024 + hh * 64, 1024, nullptr, 0};
                att::attn_unit<96, 64, false>(T, 31 - s, lds + RING_OFF, CV, cs);
                att::attn_unit<96, 64, false>(T, s, lds + RING_OFF, CV, cs);
            } else {
                att::AttnP T{PROJ + r0 * NPROJ + 512 + hh * 64, NPROJ, PROJ + r0 * NPROJ + 1024 + hh * 64, NPROJ, nullptr, 0,
                             PROJ + r0 * NPROJ + 1536 + (hh >> 1) * 128, NPROJ, (bf16*)(ws + WS_OD) + r0 * 1024 + hh * 128, 1024, args.rel_bias, hh >> 1};
                att::attn_unit<64, 128, true>(T, 31 - s, lds + RING_OFF, CV, cs);
                att::attn_unit<64, 128, true>(T, s, lds + RING_OFF, CV, cs);
            }
        }
#ifdef PROBE_ATT_MODE
        { int tid3b = threadIdx.x; asm volatile("" : "+v"(tid3b)); const int lane3 = tid3b & 63;
          LAS const float* stg_ = (LAS const float*)(lds + RING_OFF + CONV_OFF + wave3 * 4096);
          VM_WAIT();
          if (cs.pending) { att::conv_finish(CV, cs.ce, cs.cr, stg_, lane3); cs.pending = 0; }
          while (cs.next < att::CONV_NITEM) { LDS_WAIT(); att::conv_issue(CV, cs.ne, cs.nr, (unsigned)(uintptr_t)(lds + RING_OFF) + CONV_OFF + wave3 * 4096, lane3); VM_WAIT(); att::conv_finish(CV, cs.ne, cs.nr, stg_, lane3);
              cs.next += CV.stride; cs.nr += CV.stride; while (cs.nr >= att::CONV_PER_E) { cs.nr -= att::CONV_PER_E; ++cs.ne; } } }
        xcd_barrier(bar);
        const att::ConvArgs CV2{args.w1, args.w2, args.norm_ffn, ws + WS_YB, ws + WS_YB + 64 * MiB, G * NWAVES, PROBE_ATT_MODE};
        cs = att::ConvState{vcu * NWAVES + wave3, (vcu * NWAVES + wave3) / att::CONV_PER_E, (vcu * NWAVES + wave3) % att::CONV_PER_E, 0, 0, 0};
        if (PROBE_ATT_MODE == 9) cs.next = att::CONV_NITEM;
#define CV CV2
        for (int p = vcu; p < 512; p += G) {
            const int type = p >> 8, pp = p & 255, hd = pp >> 4, s = pp & 15, b = hd >> 3, hh = hd & 7;
            const size_t r0 = (size_t)b * SEQ;
            if (type == 0) {
                att::AttnP T{(const bf16*)(ws + WS_QM) + r0 * 768 + hh * 96, 768, (const bf16*)(ws + WS_KN) + r0 * 512 + hh * 64, 512, (const bf16*)(ws + WS_KR) + r0 * 32, 32,
                             (const bf16*)(ws + WS_VM) + r0 * 512 + hh * 64, 512, (bf16*)(ws + WS_YC) + r0 * 1024 + hh * 64, 1024, nullptr, 0};
                att::attn_unit<96, 64, false>(T, 31 - s, lds + RING_OFF, CV, cs);
                att::attn_unit<96, 64, false>(T, s, lds + RING_OFF, CV, cs);
            } else {
                att::AttnP T{PROJ + r0 * NPROJ + 512 + hh * 64, NPROJ, PROJ + r0 * NPROJ + 1024 + hh * 64, NPROJ, nullptr, 0,
                             PROJ + r0 * NPROJ + 1536 + (hh >> 1) * 128, NPROJ, (bf16*)(ws + WS_OD) + r0 * 1024 + hh * 128, 1024, args.rel_bias, hh >> 1};
                att::attn_unit<64, 128, true>(T, 31 - s, lds + RING_OFF, CV, cs);
                att::attn_unit<64, 128, true>(T, s, lds + RING_OFF, CV, cs);
            }
        }
#undef CV
#endif
        { int tid3b = threadIdx.x; asm volatile("" : "+v"(tid3b)); const int lane3 = tid3b & 63;
          LAS const float* stg_ = (LAS const float*)(lds + RING_OFF + CONV_OFF + wave3 * 4096);
          VM_WAIT();
          if (cs.pending) { att::conv_finish(CV, cs.ce, cs.cr, stg_, lane3); cs.pending = 0; }
          while (cs.next < att::CONV_NITEM) { LDS_WAIT(); att::conv_issue(CV, cs.ne, cs.nr, (unsigned)(uintptr_t)(lds + RING_OFF) + CONV_OFF + wave3 * 4096, lane3); VM_WAIT(); att::conv_finish(CV, cs.ne, cs.nr, stg_, lane3);
              cs.next += CV.stride; cs.nr += CV.stride; while (cs.nr >= att::CONV_PER_E) { cs.nr -= att::CONV_PER_E; ++cs.ne; } } } });
    RUN(4, { p4_combine(args, vcu, G); });
    RUN(5, {
        pg8::StaticOrder S; S.init(NTOK, DM, G, bx);
        ProbPlain P{(const bf16*)(ws + WS_YC), (const bf16*)(ws + WS_WUP), DM, DM, 0, 0, DM};
        EpiUp E{(bf16*)(ws + WS_MG), PROJ}; pg8::gemm_phase(lds + RING_OFF, P, S, E); });
    RUN(6, {
        ProbPlain P{(const bf16*)(ws + WS_MG), (const bf16*)(ws + WS_WOUT), DM, DM, 0, 0, DM};
        pg8::StaticOrder S; S.init(NTOK, DM, G, bx);
        EpiOut E{args.x, (bf16*)(ws + WS_X1), (float*)(ws + WS_SSQ2)};
        pg8::gemm_phase(lds + RING_OFF, P, S, E); });
    if (IN(7)) { p7_router(args, lds, vcu, G); SEAM(7); }
    RUN(8, {
        int tid8 = threadIdx.x; asm volatile("" : "+v"(tid8));
        build_expert_tab(ctl, tab, tid8);
        LAS unsigned short* tokT = (LAS unsigned short*)(lds + TOKT_OFF);
        EpiExp1 E{ws + WS_HB, args.b1, (LAS float*)(lds + EPI_TAB_OFF)};
        OrderExpert S{tab, 8, G, bx, 0, 1 << 30};
        pg8::Unit uu;
        if (!S.next(TOKT_UNITS, uu)) {
            ProbExp1<true> P{ws + WS_XQ, ws + WS_W1T, (const int*)(ws + WS_TOKL), tab, tokT, 512, 512};
            { const int hi8 = __builtin_amdgcn_readfirstlane(tid8 >> 8), r8 = tid8 & 255; int tk[TOKT_UNITS / 2];
              _Pragma("unroll") for (int k = 0; k < TOKT_UNITS / 2; ++k) { tk[k] = 0; if (S.next(2 * k + hi8, uu)) tk[k] = P.tok_g(uu, r8); }
              _Pragma("unroll") for (int k = 0; k < TOKT_UNITS / 2; ++k) tokT[(2 * k + hi8) * 256 + r8] = (unsigned short)tk[k]; }
            LDS_WAIT(); __syncthreads();
            pg8::gemm_phase(lds + RING_OFF, P, S, E);
        } else { ProbExp1<false> P{ws + WS_XQ, ws + WS_W1T, (const int*)(ws + WS_TOKL), tab, tokT, 512, 512}; pg8::gemm_phase(lds + RING_OFF, P, S, E); } });
    RUN(9, {
        int tid9 = threadIdx.x; asm volatile("" : "+v"(tid9));
        build_expert_tab(ctl, tab, tid9);
        ProbExp2 P{ws + WS_HB, ws + WS_W2T, 512, 512};
        OrderExpert S{tab, 4, G, bx, 0, 1 << 30};
        EpiExp2 E{ws + WS_YB, args.b2, (LAS float*)(lds + EPI_TAB_OFF)};
        pg8::gemm_phase(lds + RING_OFF, P, S, E);
#if defined(PROBE_P9_NOEPI) || defined(PROBE_P9_NOMMA)
        xcd_barrier(bar);
        { struct EpiNull { __device__ __forceinline__ void operator()(const f32x4 (&)[2][2][4][2], const pg8::Unit&, int, int, int, int) const {} } EN;
#ifdef PROBE_P9_NOMMA
          pg8::gemm_phase<EpiNull, OrderExpert, ProbExp2, true>(lds + RING_OFF, P, S, EN);
#else
          pg8::gemm_phase(lds + RING_OFF, P, S, EN);
#endif
        }
#endif
        });
    if (IN(10)) { int tid10 = threadIdx.x; asm volatile("" : "+v"(tid10)); build_expert_tab(ctl, tab, tid10); p10_final(args, tab, vcu, G); if constexpr ((MK_REPEAT >> 10) & 1) { xcd_barrier(bar); p10_final(args, tab, vcu, G); } }
#undef RUN
#undef IN
#undef BOTH
#undef SEAM
}

extern "C" void kernel_launch(void* const* d_in, const int* in_sizes, int n_in, void* d_out, int out_size, void* d_ws, size_t ws_size, hipStream_t stream) {
    static int grid = 0;
    if (grid == 0) {
        if (n_in != 22 || in_sizes[0] != NTOK * DM || out_size != NTOK * DM || ws_size < WS_END) { fprintf(stderr, "kernel_launch: unexpected shapes (n_in %d, ws %zu)\n", n_in, ws_size); grid = -1; return; }
        int dev = 0, cus = 0, per_cu = 0;
        if (hipGetDevice(&dev) != hipSuccess || hipDeviceGetAttribute(&cus, hipDeviceAttributeMultiprocessorCount, dev) != hipSuccess) { grid = -1; return; }
        if (hipFuncSetAttribute((const void*)mk_fwd, hipFuncAttributeMaxDynamicSharedMemorySize, LDS_BYTES) != hipSuccess) { fprintf(stderr, "kernel_launch: hipFuncSetAttribute failed\n"); grid = -1; return; }
        if (hipOccupancyMaxActiveBlocksPerMultiprocessor(&per_cu, (const void*)mk_fwd, NWAVES * 64, LDS_BYTES) != hipSuccess || per_cu < 1) { fprintf(stderr, "kernel_launch: occupancy query says %d\n", per_cu); }
        (void)hipGetLastError();
        grid = cus;
    }
    if (grid < 0) return;
    if (hipMemsetAsync((char*)d_ws + WS_CTL, 0, CTL_ZERO_BYTES, stream) != hipSuccess) return;
    Args a{};
    a.x = (const float*)d_in[0]; a.pos = (const int*)d_in[1]; a.norm_mix = (const float*)d_in[2]; a.w_in = (const float*)d_in[3]; a.mla_q_norm = (const float*)d_in[4];
    a.w_q_b = (const float*)d_in[5]; a.mla_kv_norm = (const float*)d_in[6]; a.w_kv_b = (const float*)d_in[7]; a.diff_lambda = (const float*)d_in[8]; a.diff_subln = (const float*)d_in[9];
    a.rel_bias = (const float*)d_in[10]; a.w_up_mla = (const float*)d_in[11]; a.w_up_diff = (const float*)d_in[12]; a.w_out = (const float*)d_in[13]; a.norm_ffn = (const float*)d_in[14];
    a.w_router = (const float*)d_in[15]; a.b_router = (const float*)d_in[16]; a.w1 = (const float*)d_in[17]; a.b1 = (const float*)d_in[18]; a.w2 = (const float*)d_in[19];
    a.b2 = (const float*)d_in[20]; a.norm_final = (const float*)d_in[21];
    a.out = (float*)d_out; a.ws = (unsigned char*)d_ws;
#if MK_N_LAUNCHES == 1
    a.ph_lo = 0; a.ph_hi = N_PHASES;
    hipLaunchKernelGGL(mk_fwd, dim3(grid), dim3(NWAVES * 64), LDS_BYTES, stream, a);
#else
    for (int p = 0; p < N_PHASES; ++p) { a.ph_lo = p; a.ph_hi = p + 1; hipLaunchKernelGGL(mk_fwd, dim3(grid), dim3(NWAVES * 64), LDS_BYTES, stream, a); }
#endif
}
```

```cpp
#include <hip/hip_runtime.h>
#include <hip/hip_bf16.h>
#include <cstdio>
#include <cstdint>
#include <cmath>

#ifndef MK_N_LAUNCHES
#define MK_N_LAUNCHES 1
#endif

namespace pg8 {
#define PG8_LAS __attribute__((address_space(3)))
typedef unsigned short bf16_t;
typedef short bf16x8 __attribute__((ext_vector_type(8)));
typedef float f32x4 __attribute__((ext_vector_type(4)));
typedef unsigned u32x4 __attribute__((ext_vector_type(4)));
typedef unsigned u32x2 __attribute__((ext_vector_type(2)));
constexpr int BM = 256, BK = 64, HALF = 128, HTB = HALF * BK * 2  , STAGE_BYTES = 8 * HTB, NXCD = 8, WGM = 8;

__host__ __device__ __forceinline__ int lds_byte(int r, int c) { const int st = (r >> 4) * 2 + (c >> 5), rr = r & 15, cc = c & 31, ob = rr * 64 + cc * 2; return st * 1024 + (ob ^ (((ob >> 9) & 1) << 5)); }
__host__ __device__ __forceinline__ void stage_rc(int b, int& R, int& C) { const int st = b / 1024, sb = b % 1024, swz = sb ^ (((sb >> 9) & 1) << 5); R = (st >> 1) * 16 + swz / 64; C = (st & 1) * 32 + (swz % 64) / 2; }
__host__ __device__ __forceinline__ int f8swz(int rr) { return (((rr >> 1) & 1) << 1) | (((rr >> 3) & 1) << 2); }
__host__ __device__ __forceinline__ int lds_byte8(int r, int k) { const int rr = r & 15; return (r >> 4) * 2048 + (rr * 8 + (k ^ f8swz(rr))) * 16; }
__host__ __device__ __forceinline__ void stage_rc8(int b, int& R, int& C) { const int g = b / 2048, s = (b % 2048) / 16, rr = s >> 3, kk = (s & 7) ^ f8swz(rr); R = g * 16 + rr; C = kk * 8; }
__host__ __device__ __forceinline__ int perm32(int rho) { const int n = rho >> 4, i = rho & 15; return 8 * (i >> 2) + 4 * n + (i & 3); }

struct Unit { int pm, pn, e, rt, ord; };

struct StaticOrder {
    int nM, nN, nwg, G, c;
    __host__ __device__ void init(int M, int N, int G_, int c_) { nM = M / BM; nN = N / BM; nwg = nM * nN; G = G_; c = c_; }
    __host__ __device__ bool next(int i, Unit& u) const {
        const long L = (long)i * G + c; if (L >= nwg) return false;
        int wgid = (int)L; { const int q = nwg / NXCD, r = nwg % NXCD, xcd = wgid % NXCD, off = wgid / NXCD; wgid = (xcd < r ? xcd * (q + 1) : r * (q + 1) + (xcd - r) * q) + off; }
        const int nig = WGM * nN, gid = wgid / nig, fm = gid * WGM, gsz = (nM - fm) < WGM ? (nM - fm) : WGM;
        u.pm = fm + ((wgid % nig) % gsz); u.pn = (wgid % nig) / gsz; u.e = 0; u.rt = 0; u.ord = i; return true;
    }
};

typedef float f32x2_cv __attribute__((ext_vector_type(2))); typedef __bf16 bf16x2_cv __attribute__((ext_vector_type(2)));
__device__ __forceinline__ unsigned cvt_pk_bf16(float lo, float hi) { const f32x2_cv v = {lo, hi}; const bf16x2_cv b = __builtin_convertvector(v, bf16x2_cv); return __builtin_bit_cast(unsigned, b); }

template <class E, class = void> struct epi_has_mid { static constexpr bool value = false; };
template <class E> struct epi_has_mid<E, decltype((void)E::HAS_MID)> { static constexpr bool value = true; };
template <class E, class = void> struct epi_has_pre { static constexpr bool value = false; };
template <class E> struct epi_has_pre<E, decltype((void)E::HAS_PRE)> { static constexpr bool value = true; };
template <class P, class = void> struct prob_is_fp8 { static constexpr bool value = false; };
template <class P> struct prob_is_fp8<P, decltype((void)P::FP8)> { static constexpr bool value = true; };
typedef int v8i_t __attribute__((ext_vector_type(8)));
typedef int v4i_t __attribute__((ext_vector_type(4)));
__device__ __forceinline__ v8i_t join8(const bf16x8& lo, const bf16x8& hi) { const v4i_t a = __builtin_bit_cast(v4i_t, lo), b = __builtin_bit_cast(v4i_t, hi); return __builtin_shufflevector(a, b, 0, 1, 2, 3, 4, 5, 6, 7); }
template <class Epi, class Sched, class Prob, bool NOMMA = false>
__device__ __forceinline__ void gemm_phase(PG8_LAS unsigned char* lds, const Prob& P, const Sched& S, const Epi& E) {
    int tid = threadIdx.x; asm volatile("" : "+v"(tid));
    const int wid = __builtin_amdgcn_readfirstlane(tid >> 6), lane = tid & 63, wr = wid >> 2, wc = wid & 3, fr = lane & 15, fq = lane >> 4;
    const int K = P.K, nt = K / BK;
    constexpr bool F8 = prob_is_fp8<Prob>::value;
    int Ra[2], Ca[2]; unsigned voffB[2];
#pragma unroll
    for (int i = 0; i < 2; ++i) { int R, C; if constexpr (F8) stage_rc8(tid * 16 + i * 8192, R, C); else stage_rc(tid * 16 + i * 8192, R, C); const int Rb = (R & ~31) + perm32(R & 31);
        Ra[i] = R; Ca[i] = C * 2; voffB[i] = (unsigned)(Rb * P.ldb + C) * 2u; }
    const size_t kstep = (size_t)(BK * 2);
    const size_t hstepB = (size_t)HALF * P.ldb * 2;
    const unsigned ldsw = (unsigned)wid * 1024u;
    const int aoff = F8 ? lds_byte8(wr * 64 + fr, fq) : lds_byte(wr * 64 + fr, fq * 8), boff = F8 ? lds_byte8(wc * 32 + fr, fq) : lds_byte(wc * 32 + fr, fq * 8);
    const int aoffh = F8 ? lds_byte8(wr * 64 + fr, fq + 4) : aoff + 1024, boffh = F8 ? lds_byte8(wc * 32 + fr, fq + 4) : boff + 1024;
#define PG8_SA(b, h) (((b) * 2 + (h)) * HTB)
#define PG8_SB(b, h) ((4 + (b) * 2 + (h)) * HTB)
#define PG8_STAGE(bufoff, gbase, voff) do { _Pragma("unroll") for (int _i = 0; _i < 2; ++_i) \
        __builtin_amdgcn_global_load_lds((const unsigned*)((const char*)(gbase) + (voff)[_i]), (PG8_LAS unsigned*)(lds + (bufoff) + ldsw + _i * 8192), 16, 0, 0); } while (0)
#define PG8_LDA(dst, b, h) do { _Pragma("unroll") for (int m = 0; m < 4; ++m) { const v4i_t lo_ = *(const PG8_LAS v4i_t*)(lds + PG8_SA(b, h) + aoff + m * 2048), hi_ = *(const PG8_LAS v4i_t*)(lds + PG8_SA(b, h) + aoffh + m * 2048); \
        dst[m] = __builtin_shufflevector(lo_, hi_, 0, 1, 2, 3, 4, 5, 6, 7); } } while (0)
#define PG8_LDB(dst, b, h) do { _Pragma("unroll") for (int n = 0; n < 2; ++n) { const v4i_t lo_ = *(const PG8_LAS v4i_t*)(lds + PG8_SB(b, h) + boff + n * 2048), hi_ = *(const PG8_LAS v4i_t*)(lds + PG8_SB(b, h) + boffh + n * 2048); \
        dst[n] = __builtin_shufflevector(lo_, hi_, 0, 1, 2, 3, 4, 5, 6, 7); } } while (0)
#define PG8_LO(x) __builtin_bit_cast(bf16x8, __builtin_shufflevector(x, x, 0, 1, 2, 3))
#define PG8_HI(x) __builtin_bit_cast(bf16x8, __builtin_shufflevector(x, x, 4, 5, 6, 7))
#define PG8_MMA(FIRST, ai, bj, At, Bt) do { __builtin_amdgcn_s_setprio(1); if constexpr (!NOMMA) { \
        if constexpr (F8) { _Pragma("unroll") for (int m = 0; m < 4; ++m) _Pragma("unroll") for (int n = 0; n < 2; ++n) {   \
            if constexpr (FIRST) asm volatile("v_mfma_scale_f32_16x16x128_f8f6f4 %0, %1, %2, 0, %3, %3 op_sel_hi:[0,0,0]" : "=&v"(acc[ai][bj][m][n]) : "v"(Bt[n]), "v"(At[m]), "v"(sc8)); \
            else asm volatile("v_mfma_scale_f32_16x16x128_f8f6f4 %0, %1, %2, %0, %3, %3 op_sel_hi:[0,0,0]" : "+v"(acc[ai][bj][m][n]) : "v"(Bt[n]), "v"(At[m]), "v"(sc8)); } } \
        else {   \
            _Pragma("unroll") for (int m = 0; m < 4; ++m) _Pragma("unroll") for (int n = 0; n < 2; ++n) { \
                if constexpr (FIRST) asm volatile("v_mfma_f32_16x16x32_bf16 %0, %1, %2, 0" : "=&v"(acc[ai][bj][m][n]) : "v"(PG8_LO(Bt[n])), "v"(PG8_LO(At[m]))); \
                else asm volatile("v_mfma_f32_16x16x32_bf16 %0, %1, %2, %0" : "+v"(acc[ai][bj][m][n]) : "v"(PG8_LO(Bt[n])), "v"(PG8_LO(At[m]))); } \
            _Pragma("unroll") for (int m = 0; m < 4; ++m) _Pragma("unroll") for (int n = 0; n < 2; ++n) \
                asm volatile("v_mfma_f32_16x16x32_bf16 %0, %1, %2, %0" : "+v"(acc[ai][bj][m][n]) : "v"(PG8_HI(Bt[n])), "v"(PG8_HI(At[m]))); } } \
        __builtin_amdgcn_s_setprio(0); } while (0)
#define PG8_WAIT_V(n) asm volatile("s_waitcnt vmcnt(" #n ")" ::: "memory")
#define PG8_WAIT_L(n) asm volatile("s_waitcnt lgkmcnt(" #n ")" ::: "memory")
#define PG8_BAR __builtin_amdgcn_s_barrier()
#define PG8_SCHED __builtin_amdgcn_sched_barrier(0)
#define PG8_AOFF(dst, u) do { _Pragma("unroll") for (int _h = 0; _h < 2; ++_h) _Pragma("unroll") for (int _i = 0; _i < 2; ++_i) { dst[_h][_i] = P.a_off(u, _h * HALF + Ra[_i]) + (unsigned)Ca[_i]; asm volatile("" : "+v"(dst[_h][_i])); } } while (0)
    Unit cur, nxt; int ui = 0;
    if (!S.next(0, cur)) return;
    f32x4 acc[2][2][4][2];
#define PG8_ZERO_ACC do { _Pragma("unroll") for (int a = 0; a < 2; ++a) _Pragma("unroll") for (int b = 0; b < 2; ++b) _Pragma("unroll") for (int m = 0; m < 4; ++m) _Pragma("unroll") for (int n = 0; n < 2; ++n) acc[a][b][m][n] = (f32x4){0.f, 0.f, 0.f, 0.f}; } while (0)
    const int sc8 = 0x7F7F7F7F;
    v8i_t At[4], B0[2], B1[2];
    unsigned cvA[2][2], nvA[2][2];
    PG8_AOFF(cvA, cur);
    const char* const cA = P.a_base(); const char* cB = P.b_base(cur);
    PG8_STAGE(PG8_SB(0, 0), cB, voffB); PG8_STAGE(PG8_SB(0, 1), cB + hstepB, voffB); PG8_STAGE(PG8_SA(0, 0), cA, cvA[0]); PG8_STAGE(PG8_SA(0, 1), cA, cvA[1]);
    if (wr == 1) PG8_BAR;
    PG8_WAIT_V(2); PG8_BAR;
    PG8_STAGE(PG8_SB(1, 0), cB + kstep, voffB); PG8_STAGE(PG8_SA(1, 0), cA + kstep, cvA[0]); PG8_STAGE(PG8_SB(1, 1), cB + hstepB + kstep, voffB);
    PG8_WAIT_V(6); PG8_BAR;
    for (;;) {
        const bool has_next = S.next(ui + 1, nxt);
        const char* nB = cB;
        if (has_next) { nB = P.b_base(nxt); PG8_AOFF(nvA, nxt); }
        else {
#pragma unroll
            for (int _h = 0; _h < 2; ++_h)
#pragma unroll
                for (int _i = 0; _i < 2; ++_i) nvA[_h][_i] = cvA[_h][_i];
        }
        if constexpr (epi_has_pre<Epi>::value) E.pre(cur, wid, lane);
#define PG8_KITER(FIRST) do { \
            if constexpr (!(FIRST) && epi_has_mid<Epi>::value) { if (t == nt / 2) { asm volatile("s_nop 15\n\ts_nop 3" ::: "memory"); E.mid(acc, cur, wr, wc, fr, fq); } }        \
            const bool last = (t == nt - 2); \
            const char* a1 = cA + (size_t)(t + 1) * kstep;                                             \
            const char* a2 = last ? cA : cA + (size_t)(t + 2) * kstep; const char* b2 = last ? nB : cB + (size_t)(t + 2) * kstep;     \
            const char* a3 = a2 + kstep; const char* b3 = b2 + kstep;                                \
            unsigned xv0[2], xv1[2];                                                                \
            _Pragma("unroll") for (int _i = 0; _i < 2; ++_i) { xv0[_i] = last ? nvA[0][_i] : cvA[0][_i]; xv1[_i] = last ? nvA[1][_i] : cvA[1][_i]; } \
              \
            PG8_LDB(B0, 0, 0); PG8_LDB(B1, 0, 1); PG8_SCHED; PG8_LDA(At, 0, 0); PG8_WAIT_L(0); PG8_SCHED; PG8_STAGE(PG8_SA(1, 1), a1, cvA[1]); \
            PG8_WAIT_V(8); PG8_BAR; PG8_MMA(FIRST, 0, 0, At, B0); PG8_MMA(FIRST, 0, 1, At, B1); PG8_BAR; PG8_SCHED; \
              \
            PG8_LDA(At, 0, 1); PG8_WAIT_L(0); PG8_SCHED; PG8_STAGE(PG8_SB(0, 0), b2, voffB); PG8_STAGE(PG8_SB(0, 1), b2 + hstepB, voffB); PG8_STAGE(PG8_SA(0, 0), a2, xv0); \
            PG8_WAIT_V(8); PG8_BAR; PG8_MMA(FIRST, 1, 0, At, B0); PG8_MMA(FIRST, 1, 1, At, B1); PG8_BAR; PG8_SCHED; \
              \
            PG8_LDB(B0, 1, 0); PG8_LDB(B1, 1, 1); PG8_SCHED; PG8_LDA(At, 1, 0); PG8_WAIT_L(0); PG8_SCHED; PG8_STAGE(PG8_SA(0, 1), a2, xv1); \
            PG8_WAIT_V(8); PG8_BAR; PG8_MMA(false, 0, 0, At, B0); PG8_MMA(false, 0, 1, At, B1); PG8_BAR; PG8_SCHED; \
              \
            PG8_LDA(At, 1, 1); PG8_WAIT_L(0); PG8_SCHED; PG8_STAGE(PG8_SB(1, 0), b3, voffB); PG8_STAGE(PG8_SB(1, 1), b3 + hstepB, voffB); PG8_STAGE(PG8_SA(1, 0), a3, xv0); \
            PG8_WAIT_V(8); PG8_BAR; PG8_MMA(false, 1, 0, At, B0); PG8_MMA(false, 1, 1, At, B1); PG8_BAR; PG8_SCHED; \
        } while (0)
        { const int t = 0; PG8_KITER(true); }
        for (int t = 2; t < nt; t += 2) { PG8_KITER(false); }
#undef PG8_KITER
        if (wr == 0) PG8_BAR;
        asm volatile("s_nop 15\n\ts_nop 3" ::: "memory");
        E(acc, cur, wr, wc, fr, fq);
#ifdef PG8_DUP_EPI
        E(acc, cur, wr, wc, fr, fq);
#endif
        if (!has_next) break;
        cur = nxt; cB = nB; ++ui;
#pragma unroll
        for (int _h = 0; _h < 2; ++_h)
#pragma unroll
            for (int _i = 0; _i < 2; ++_i) cvA[_h][_i] = nvA[_h][_i];
        if (wr == 1) PG8_BAR;
    }
    PG8_WAIT_V(0);
    PG8_BAR;
#undef PG8_SA
#undef PG8_SB
#undef PG8_STAGE
#undef PG8_LDA
#undef PG8_LDB
#undef PG8_LO
#undef PG8_HI
#undef PG8_MMA
#undef PG8_WAIT_V
#undef PG8_WAIT_L
#undef PG8_BAR
#undef PG8_SCHED
#undef PG8_AOFF
#undef PG8_ZERO_ACC
}
}

#define GAS __attribute__((address_space(1)))
#define LAS __attribute__((address_space(3)))
typedef unsigned short bf16;
typedef unsigned v4u __attribute__((ext_vector_type(4)));
typedef unsigned v2u __attribute__((ext_vector_type(2)));
typedef float f32x4 __attribute__((ext_vector_type(4)));
typedef float f32x2 __attribute__((ext_vector_type(2)));
typedef GAS unsigned gu32;
#define RLX_AGENT __ATOMIC_RELAXED, __HIP_MEMORY_SCOPE_AGENT
#define LDS_WAIT() asm volatile("s_waitcnt lgkmcnt(0)" ::: "memory")
#define VM_WAIT() asm volatile("s_waitcnt vmcnt(0)" ::: "memory")
__device__ __forceinline__ unsigned f2bf(float f) { unsigned u = __builtin_bit_cast(unsigned, f); return (u + 0x7fffu + ((u >> 16) & 1u)) >> 16; }
__device__ __forceinline__ unsigned pk2(float lo, float hi) { return f2bf(lo) | (f2bf(hi) << 16); }
__device__ __forceinline__ float bf2f(unsigned h) { return __builtin_bit_cast(float, h << 16); }
__device__ __forceinline__ float wave_sum(float v) {
#pragma unroll
    for (int o = 1; o < 64; o <<= 1) v += __shfl_xor(v, o);
    return v;
}

constexpr int NWAVES = 8;
constexpr int NTOK = 16384, SEQ = 8192, DM = 1024, NPROJ = 4096, NE = 32, INT_TOTAL = 4000;
constexpr float EPS = 1e-5f, LOG2E = 1.4426950408889634f;
constexpr float C2D = 0.125f * LOG2E;
constexpr float C2M = 0.10206207261596577f * LOG2E;
constexpr float W8_SCALE = 32.0f;
constexpr float X8_SCALE = 16.0f;
constexpr float H8_SCALE = 4.0f;
constexpr float Y8_SCALE = 16.0f;
constexpr int HCAP = 73728;

constexpr size_t MiB = 1u << 20, KiB = 1u << 10;
constexpr size_t WS_CTL = 0, CTL_ZERO_BYTES = 32 * KiB;
constexpr size_t WS_WQ = 1 * MiB, WS_WKV = 1 * MiB + 512 * KiB, WS_WUP = 2 * MiB, WS_WOUT = 4 * MiB, WS_WR = 6 * MiB, WS_RX = 6 * MiB + 256 * KiB;
constexpr size_t WS_SSQQ = 6 * MiB + 512 * KiB, WS_SSQKV = 6 * MiB + 768 * KiB, WS_SSQ2 = 7 * MiB, WS_WIN = 8 * MiB, WS_CS = 16 * MiB, WS_TOKL = 18 * MiB;
constexpr size_t WS_SEL = 20 * MiB, WS_WTS = 20 * MiB + 256 * KiB, WS_R2 = 20 * MiB + 512 * KiB, WS_KR = 21 * MiB;
constexpr size_t WS_W1T = 24 * MiB, WS_W2T = 152 * MiB, WS_XB = 216 * MiB, WS_PROJ = 248 * MiB, WS_QM = 376 * MiB, WS_KN = 400 * MiB, WS_VM = 416 * MiB;
constexpr size_t WS_YC = 432 * MiB, WS_OD = 464 * MiB, WS_T1 = 496 * MiB, WS_MG = 528 * MiB, WS_X1 = 560 * MiB, WS_X1B = 624 * MiB, WS_YB = 656 * MiB, WS_END = 800 * MiB;
constexpr size_t WS_XQ = WS_X1B;
constexpr size_t WS_XB8 = WS_X1B + 16 * MiB;
constexpr size_t WS_WING8 = WS_WIN + 4 * MiB;
constexpr size_t WS_HB = WS_PROJ;
static_assert(WS_HB + (size_t)HCAP * 1024 * 2 <= WS_KN, "HB overlay");
constexpr int CW_TMO = 0, CW_GCNT = 64  , CW_BAR = 4096;

constexpr int RING_OFF = 0, RING_BYTES = 131072;
constexpr int CONV_OFF = 125440;
constexpr int LDSCTL_OFF = 155 * 1024, MISC_OFF = LDSCTL_OFF + 320;
constexpr int TAB_OFF = LDSCTL_OFF + 1024;
constexpr int EPI_TAB_OFF = 140 * 1024;
constexpr int LDS_BYTES = 163840;
#define XB_TMO      128
#define XB_XCNT(j)  (256  + 64 * (j))
#define XB_XSUB(j)  (1280 + 64 * (j))
#define XB_XGEN(j)  (2304 + 64 * (j))
#define XB_TOP      3328
#define XB_TOPGEN   3392
#define XCD_BAR_WORDS 3456
#define XB_SPIN_CAP (1u << 18)

__device__ __forceinline__ unsigned xb_ld(unsigned* p)              { return __hip_atomic_load(p, __ATOMIC_RELAXED, __HIP_MEMORY_SCOPE_AGENT); }
__device__ __forceinline__ unsigned xb_add(unsigned* p, unsigned v) { return __hip_atomic_fetch_add(p, v, __ATOMIC_RELAXED, __HIP_MEMORY_SCOPE_AGENT); }
__device__ __forceinline__ unsigned xb_xcc_id() { return (unsigned)__builtin_amdgcn_s_getreg((3 << 11) | 20) & 0xFu; }
#define XB_SPIN(cond, bar) do { unsigned _sp = 0; while (cond) { __builtin_amdgcn_s_sleep(1); \
    if ((++_sp & 255u) == 0u) { if (xb_ld(&(bar)[XB_TMO])) break; if (_sp > XB_SPIN_CAP) { atomicAdd(&(bar)[XB_TMO], 1u); break; } } } } while (0)

struct XcdBarrier {
    unsigned* bar; unsigned x;
    volatile LAS unsigned* st;
};

__device__ __forceinline__ XcdBarrier xcd_barrier_post(unsigned* bar, volatile LAS unsigned* st) {
    XcdBarrier b; b.bar = bar; b.x = xb_xcc_id(); b.st = st;
    if (threadIdx.x == 0) (void)xb_add(&bar[XB_XCNT(b.x)], 1u);
    return b;
}
__device__ __forceinline__ void xcd_barrier_complete(unsigned* bar, unsigned x, unsigned& nloc, unsigned& nx) {
    const unsigned G = gridDim.x * gridDim.y * gridDim.z;
    unsigned sum, cnt, mine, sp = 0u;
    for (;;) {
        sum = 0u; cnt = 0u; mine = 0u;
#pragma unroll
        for (unsigned j = 0; j < 16; ++j) { const unsigned c = xb_ld(&bar[XB_XCNT(j)]); sum += c; cnt += (c > 0u) ? 1u : 0u; mine = (j == x) ? c : mine; }
        if (sum == G) break;
        __builtin_amdgcn_s_sleep(1);
        if ((++sp & 255u) == 0u) { if (xb_ld(&bar[XB_TMO])) break; if (sp > XB_SPIN_CAP) { atomicAdd(&bar[XB_TMO], 1u); break; } }
    }
    nloc = mine > 0u ? mine : 1u; nx = cnt > 0u ? cnt : 1u;
}

__device__ __forceinline__ void xcd_barrier(const XcdBarrier& b) {
    asm volatile("s_waitcnt vmcnt(0)" ::: "memory");
    __syncthreads();
    if (threadIdx.x == 0) {
        unsigned* bar = b.bar;
        __builtin_amdgcn_s_waitcnt(0);
        unsigned nloc = b.st[0], nx = b.st[1];
        if (nloc == 0u) { xcd_barrier_complete(bar, b.x, nloc, nx); b.st[0] = nloc; b.st[1] = nx; }
        const unsigned old = xb_add(&bar[XB_XSUB(b.x)], 1u);
        const unsigned gen = old / nloc;
        if (old + 1u == (gen + 1u) * nloc) {
            __builtin_amdgcn_fence(__ATOMIC_RELEASE, "agent");
            asm volatile("s_waitcnt vmcnt(0)" ::: "memory");
            const unsigned og = xb_add(&bar[XB_TOP], 1u);
            const unsigned tg = og / nx;
            if (og + 1u == (tg + 1u) * nx) xb_add(&bar[XB_TOPGEN], 1u);
            else XB_SPIN(xb_ld(&bar[XB_TOPGEN]) == tg, bar);
            __builtin_amdgcn_fence(__ATOMIC_ACQUIRE, "agent");
            asm volatile("s_waitcnt vmcnt(0)" ::: "memory");
        } else {
            XB_SPIN(xb_ld(&bar[XB_TOPGEN]) == gen, bar);
            __builtin_amdgcn_fence(__ATOMIC_ACQUIRE, "agent");
            asm volatile("s_waitcnt vmcnt(0)" ::: "memory");
        }
    }
    __syncthreads();
}

struct Args {
    const float* x; const int* pos; const float* norm_mix; const float* w_in; const float* mla_q_norm; const float* w_q_b; const float* mla_kv_norm; const float* w_kv_b;
    const float* diff_lambda; const float* diff_subln; const float* rel_bias; const float* w_up_mla; const float* w_up_diff; const float* w_out; const float* norm_ffn;
    const float* w_router; const float* b_router; const float* w1; const float* b1; const float* w2; const float* b2; const float* norm_final;
    float* out; unsigned char* ws; int ph_lo, ph_hi;
};

__device__ __forceinline__ int rope_dim(int p) { return 16 * ((p >> 2) & 1) + 4 * (p >> 3) + (p & 3); }

__device__ __forceinline__ unsigned pk4_fp8(float a, float b, float c, float d) { int w = __builtin_amdgcn_cvt_pk_fp8_f32(a, b, 0, false); w = __builtin_amdgcn_cvt_pk_fp8_f32(c, d, w, true); return (unsigned)w; }
template <bool OUT8, class Map>
__device__ __forceinline__ void tr_item(const float* src, int lds_, int Ksrc, void* dstv, int ldd, int koff, const Map& map, LAS float* scr, int kb, int nb, int lane) {
    const int k0 = 64 * kb, n0 = 64 * nb, c = lane & 15, kq = lane >> 4;
    const int col = map.col(n0 + 4 * c);
    f32x4 v[16];
#pragma unroll
    for (int j = 0; j < 16; ++j) { const int k = k0 + 4 * j + kq; v[j] = (f32x4){0.f, 0.f, 0.f, 0.f};
        if (col >= 0 && k < Ksrc) v[j] = *(const GAS f32x4*)(src + (size_t)k * lds_ + col); }
#pragma unroll
    for (int j = 0; j < 16; ++j) { const int k = k0 + 4 * j + kq; const float sc = (k < Ksrc) ? map.scale(k) : 0.f;
#pragma unroll
        for (int i = 0; i < 4; ++i) scr[(4 * c + i) * 65 + 4 * j + kq] = v[j][i] * sc; }
    LDS_WAIT(); asm volatile("" ::: "memory");
    const int cc = lane & 7;
#pragma unroll
    for (int jj = 0; jj < 8; ++jj) { const int n = (lane >> 3) + 8 * jj; const LAS float* s = scr + n * 65 + 8 * cc;
        if constexpr (OUT8) { v2u o; o.x = pk4_fp8(s[0], s[1], s[2], s[3]); o.y = pk4_fp8(s[4], s[5], s[6], s[7]);
            *(GAS v2u*)((unsigned char*)dstv + (size_t)(n0 + n) * ldd + koff + k0 + 8 * cc) = o; }
        else { v4u o; o.x = pk2(s[0], s[1]); o.y = pk2(s[2], s[3]); o.z = pk2(s[4], s[5]); o.w = pk2(s[6], s[7]);
            *(GAS v4u*)((bf16*)dstv + (size_t)(n0 + n) * ldd + koff + k0 + 8 * cc) = o; } }
    LDS_WAIT(); asm volatile("" ::: "memory");
}
struct MapWin { const float* g; __device__ int col(int n) const { if (n < 384) return n; if (n < 416) return 384 + rope_dim(n - 384); if (n < 512) return -1; if (n < 2048) return n - 96; return 1952 + ((n >> 7) & 1) * 1024 + ((n - 2048) >> 8) * 128 + (n & 127); }        __device__ float scale(int k) const { return g[k]; } };
struct MapWin8 { const float* g; __device__ int col(int n) const { return 1952 + ((n >> 7) & 1) * 1024 + ((n - 2048) >> 8) * 128 + (n & 127); } __device__ float scale(int k) const { return g[k] * W8_SCALE; } };
struct MapWq { const float* g; __device__ int col(int n) const { if (n < 512) return (n >> 6) * 96 + (n & 63); const int h = (n - 512) >> 5; return h * 96 + 64 + rope_dim((n - 512) & 31); } __device__ float scale(int k) const { return g[k]; } };
struct MapWkv { const float* g; __device__ int col(int n) const { if (n < 512) return (n >> 6) * 128 + (n & 63); return ((n - 512) >> 6) * 128 + 64 + (n & 63); } __device__ float scale(int k) const { return g[k]; } };
struct MapId { __device__ int col(int n) const { return n; } __device__ float scale(int) const { return 1.f; } };
struct MapW2 { __device__ int col(int n) const { return n; } __device__ float scale(int) const { return W8_SCALE; } };
struct MapUpDiff { const float* g; __device__ int col(int n) const { return n; } __device__ float scale(int k) const { return 0.8f * g[k & 127]; } };
struct MapW1 { const float* g; __device__ int col(int n) const { return ((n >> 7) & 1) * 1024 + (n >> 8) * 128 + (n & 127); } __device__ float scale(int k) const { return g[k] * W8_SCALE; } };

__device__ __forceinline__ void rope_cs(int pos, int j, float& c, float& s) {
    const float freq = exp2f(-(float)j * (13.287712379549449f / 16.0f));
    const float angf = (float)pos * freq;
    const double a = (double)angf;
    const double TWO_PI = 6.283185307179586476925286766559;
    const double r = a - TWO_PI * rint(a / TWO_PI);
    const float rf = (float)r;
    c = __cosf(rf); s = __sinf(rf);
}

__device__ __forceinline__ void p0_prologue(const Args& a, LAS unsigned char* lds, int vcu, int G) {
    int tid = threadIdx.x; asm volatile("" : "+v"(tid)); const int lane = tid & 63, wave = __builtin_amdgcn_readfirstlane(tid >> 6);
    unsigned char* ws = a.ws;
    LAS float* scr = (LAS float*)(lds + RING_OFF + wave * 16640);
    const int gw = vcu * NWAVES + wave, NGW = G * NWAVES;
    { constexpr int I_IN = 64 * 16, I_Q = 12 * 4, I_KV = 16 * 4, I_UA = 16 * 8, I_UB = 16 * 8, I_O = 16 * 16, TOT = I_IN + I_Q + I_KV + I_UA + I_UB + I_O;
      const MapWin mwin{a.norm_mix}; const MapWin8 mwin8{a.norm_mix}; const MapWq mwq{a.mla_q_norm}; const MapWkv mwkv{a.mla_kv_norm}; const MapId mi{}; const MapUpDiff mud{a.diff_subln};
      for (int it = gw; it < TOT; it += NGW) {
          int r = it;
          if (r < I_IN) { if ((r >> 4) < 32) tr_item<false>(a.w_in, INT_TOTAL, 1024, (bf16*)(ws + WS_WIN), 1024, 0, mwin, scr, r & 15, r >> 4, lane);
                          else tr_item<true>(a.w_in, INT_TOTAL, 1024, ws + WS_WING8 - (size_t)2048 * 1024, 1024, 0, mwin8, scr, r & 15, r >> 4, lane);
                          continue; } r -= I_IN;
          if (r < I_Q) { tr_item<false>(a.w_q_b, 768, 256, (bf16*)(ws + WS_WQ), 256, 0, mwq, scr, r & 3, r >> 2, lane); continue; } r -= I_Q;
          if (r < I_KV) { tr_item<false>(a.w_kv_b, 1024, 128, (bf16*)(ws + WS_WKV), 256, 0, mwkv, scr, r & 3, r >> 2, lane); continue; } r -= I_KV;
          if (r < I_UA) { tr_item<false>(a.w_up_mla, 1024, 512, (bf16*)(ws + WS_WUP), 1024, 0, mi, scr, r & 7, r >> 3, lane); continue; } r -= I_UA;
          if (r < I_UB) { tr_item<false>(a.w_up_diff, 1024, 512, (bf16*)(ws + WS_WUP), 1024, 512, mud, scr, r & 7, r >> 3, lane); continue; } r -= I_UB;
          tr_item<false>(a.w_out, 1024, 1024, (bf16*)(ws + WS_WOUT), 1024, 0, mi, scr, r & 15, r >> 4, lane);
      } }
    { bf16* XB = (bf16*)(ws + WS_XB); float* RX = (float*)(ws + WS_RX);
      for (int m0 = gw; m0 < NTOK; m0 += 2 * NGW) {
          f32x4 v[2][4];
#pragma unroll
          for (int q = 0; q < 2; ++q) { const int m = m0 + q * NGW; const GAS f32x4* xr = (const GAS f32x4*)(a.x + (size_t)(m < NTOK ? m : m0) * DM) + lane;
#pragma unroll
              for (int j = 0; j < 4; ++j) v[q][j] = xr[64 * j]; }
#pragma unroll
          for (int q = 0; q < 2; ++q) { const int m = m0 + q * NGW; float s = 0.f;
#pragma unroll
              for (int j = 0; j < 4; ++j) s += (v[q][j].x * v[q][j].x + v[q][j].y * v[q][j].y) + (v[q][j].z * v[q][j].z + v[q][j].w * v[q][j].w);
              s = wave_sum(s);
              if (m < NTOK) { if (lane == 0) RX[m] = rsqrtf(s * (1.f / DM) + EPS);
                  GAS unsigned long long* o8 = (GAS unsigned long long*)(XB + (size_t)m * DM) + lane;
#pragma unroll
                  for (int j = 0; j < 4; ++j) o8[64 * j] = (unsigned long long)pk2(v[q][j].x, v[q][j].y) | ((unsigned long long)pk2(v[q][j].z, v[q][j].w) << 32);
                  GAS unsigned* o4 = (GAS unsigned*)(ws + WS_XB8 + (size_t)m * DM) + lane;
#pragma unroll
                  for (int j = 0; j < 4; ++j) o4[64 * j] = pk4_fp8(v[q][j].x * X8_SCALE, v[q][j].y * X8_SCALE, v[q][j].z * X8_SCALE, v[q][j].w * X8_SCALE); } }
      } }
    { f32x2* CS = (f32x2*)(ws + WS_CS); float* WR = (float*)(ws + WS_WR);
      const int gt = vcu * NWAVES * 64 + tid, NGT = G * NWAVES * 64;
      for (int i = gt; i < NTOK * 16; i += NGT) { float c, s; rope_cs(a.pos[i >> 4], i & 15, c, s); CS[i] = (f32x2){c, s}; }
      for (int i = gt; i < DM * NE; i += NGT) { const int e = i >> 10, k = i & 1023; WR[i] = a.w_router[k * NE + e] * a.norm_ffn[k]; }
    }
}

using pg8::Unit; using pg8::HALF;
struct ProbPlain {
    const bf16* A; const bf16* Bt; int lda, ldb, acol, bcol, K;
    __device__ __forceinline__ const char* a_base() const { return (const char*)A; }
    __device__ __forceinline__ unsigned a_off(const Unit& u, int r) const { return (unsigned)(((u.pm * 256 + r) * lda + acol) * 2); }
    __device__ __forceinline__ const char* b_base(const Unit& u) const { return (const char*)(Bt + (size_t)u.pn * 256 * ldb + bcol); }
};
struct ProbPlain8 {
    static constexpr bool FP8 = true;
    const unsigned char* A; const unsigned char* Bt; int K, ldb;
    __device__ __forceinline__ const char* a_base() const { return (const char*)A; }
    __device__ __forceinline__ unsigned a_off(const Unit& u, int r) const { return (unsigned)(u.pm * 256 + r) * 1024u; }
    __device__ __forceinline__ const char* b_base(const Unit& u) const { return (const char*)(Bt + (size_t)u.pn * 256 * 1024); }
};
__device__ __forceinline__ float sigmoidf_(float v) { return __builtin_amdgcn_rcpf(1.f + __builtin_amdgcn_exp2f(-LOG2E * v)); }
__device__ __forceinline__ v4u pack8(const f32x4& v0, const f32x4& v1) { v4u w; w.x = pg8::cvt_pk_bf16(v0[0], v0[1]); w.y = pg8::cvt_pk_bf16(v0[2], v0[3]); w.z = pg8::cvt_pk_bf16(v1[0], v1[1]); w.w = pg8::cvt_pk_bf16(v1[2], v1[3]); return w; }
__device__ __forceinline__ float dot4(const f32x4& v) { return (v[0] * v[0] + v[1] * v[1]) + (v[2] * v[2] + v[3] * v[3]); }

struct EpiInProj {
    bf16* PROJ; bf16* KR; const float* RX; const f32x2* CS; float* SSQ_Q; float* SSQ_KV; LAS float* tl; int pn0; float asc;
    static constexpr bool HAS_PRE = true;
    __device__ __forceinline__ void pre(const Unit& u, int wid, int lane) const {
        if (wid == 7) __builtin_amdgcn_global_load_lds((const unsigned*)(RX + u.pm * 256 + lane * 4), (LAS unsigned*)(tl + (u.ord & 1) * 256), 16, 0, 0); }
    __device__ __forceinline__ void operator()(const f32x4 (&acc)[2][2][4][2], const Unit& u, int wr, int wc, int fr, int fq) const {
        const int pn = u.pn + pn0; const float sc = ((pn == 2 || pn == 3) ? C2D : 1.f) * asc;
#pragma unroll
        for (int ai = 0; ai < 2; ++ai)
#pragma unroll
            for (int m = 0; m < 4; ++m) {
                const int row = u.pm * 256 + ai * HALF + wr * 64 + m * 16 + fr;
                const float rx = tl[(u.ord & 1) * 256 + ai * HALF + wr * 64 + m * 16 + fr] * sc; float ssq = 0.f;
                f32x4 v[2][2];
#pragma unroll
                for (int bj = 0; bj < 2; ++bj) { v[bj][0] = acc[ai][bj][m][0] * rx; v[bj][1] = acc[ai][bj][m][1] * rx; }
                if (pn >= 8) {
#pragma unroll
                    for (int n = 0; n < 2; ++n)
#pragma unroll
                        for (int i = 0; i < 4; ++i) { const float em1 = 1.f + __builtin_amdgcn_exp2f(-LOG2E * v[0][n][i]), ed1 = 1.f + __builtin_amdgcn_exp2f(-LOG2E * v[1][n][i]);
                            v[1][n][i] = __builtin_amdgcn_rcpf(ed1); v[0][n][i] = ed1 * __builtin_amdgcn_rcpf(em1); } }
                if (pn == 0) ssq += (dot4(v[0][0]) + dot4(v[0][1])) + (dot4(v[1][0]) + dot4(v[1][1]));
                if (pn == 1) ssq += dot4(v[0][0]) + dot4(v[0][1]);
                if (pn == 1 && wc == 0) {
                    const f32x4 cs0 = *(const f32x4*)(CS + (size_t)row * 16 + 4 * fq), cs1 = *(const f32x4*)(CS + (size_t)row * 16 + 4 * fq + 2);
                    const float c[4] = {cs0[0], cs0[2], cs1[0], cs1[2]}, s[4] = {cs0[1], cs0[3], cs1[1], cs1[3]};
                    f32x4 o1, o2;
#pragma unroll
                    for (int i = 0; i < 4; ++i) { o1[i] = v[1][0][i] * c[i] - v[1][1][i] * s[i]; o2[i] = v[1][0][i] * s[i] + v[1][1][i] * c[i]; }
                    *(v4u*)(KR + (size_t)row * 32 + 8 * fq) = pack8(o1, o2);
                }
#pragma unroll
                for (int bj = 0; bj < 2; ++bj) *(v4u*)(PROJ + (size_t)row * NPROJ + pn * 256 + bj * HALF + wc * 32 + 8 * fq) = pack8(v[bj][0], v[bj][1]);
                if (pn <= 1) { ssq += __shfl_xor(ssq, 16); ssq += __shfl_xor(ssq, 32); if (fq == 0) *(float*)((char*)SSQ_Q + (size_t)pn * (WS_SSQKV - WS_SSQQ) + ((size_t)row * 4 + wc) * 4) = ssq; }
            }
    }
};

struct ProbQKV {
    const bf16* PROJ; const bf16* WQ; const bf16* WKV; int K, ldb;
    __device__ __forceinline__ const char* a_base() const { return (const char*)PROJ; }
    __device__ __forceinline__ unsigned a_off(const Unit& u, int r) const { return (unsigned)(((u.pm * 256 + r) * NPROJ + (u.e ? 256 : 0)) * 2); }
    __device__ __forceinline__ const char* b_base(const Unit& u) const { return (const char*)WQ + (size_t)u.e * (WS_WKV - WS_WQ) + (size_t)u.pn * (256 * 256 * 2); }
};
struct OrderQKV { int G, c;
    __device__ __forceinline__ bool next(int i, Unit& u) const { const int L = i * G + c; if (L >= 448) return false;
        if (L < 192) { u.e = 0; u.pm = L / 3; u.pn = L % 3; } else { const int l2 = L - 192; u.e = 1; u.pm = l2 >> 2; u.pn = l2 & 3; } u.rt = 0; u.ord = i; return true; } };
struct OrderIn16 { int G, c;
    __device__ __forceinline__ static int cnt(int v) { return v < 64 ? 2 : v < 128 ? 1 : (v < 192 ? 4 : 1); }
    __device__ __forceinline__ static void unit(int v, int i, Unit& u) {
        if (v < 128 && i == 0) { u.pm = v & 63; u.pn = v >> 6; return; }
        const int t = v < 64 ? v : v < 192 ? 64 + 4 * (v - 128) + i : 320 + (v - 192); u.pm = t / 6; u.pn = 2 + t % 6; }
    __device__ __forceinline__ bool next(int i, Unit& u) const { u.e = 0; u.rt = 0; u.ord = i;
        for (int v = c; v < 256; v += G) { const int n = cnt(v); if (i < n) { unit(v, i, u); return true; } i -= n; } return false; } };
struct OrderIn8 { int G, c;
    __device__ __forceinline__ static int cnt(int v) { return v < 64 ? 1 : v < 128 ? 2 : v < 192 ? 0 : 5; }
    __device__ __forceinline__ static int first(int v) { return v < 64 ? v : v < 128 ? 64 + 2 * (v - 64) : 192 + 5 * (v - 192); }
    __device__ __forceinline__ bool next(int i, Unit& u) const { u.e = 0; u.rt = 0; u.ord = i;
        for (int v = c; v < 256; v += G) { const int n = cnt(v); if (i < n) { const int s = first(v) + i; u.pm = s >> 3; u.pn = s & 7; return true; } i -= n; } return false; } };
struct OrderQKV2 { int G, c;
    __device__ __forceinline__ bool next(int i, Unit& u) const { u.rt = 0; u.ord = i;
        for (int v = c; v < 128; v += G) { const int n = v < 64 ? 3 : 4; if (i < n) { u.e = v >> 6; u.pm = v & 63; u.pn = i; return true; } i -= n; } return false; } };
struct EpiQKV {
    bf16* QM; bf16* KN; bf16* VM; const float* SSQ_Q; const float* SSQ_KV; const f32x2* CS;
    __device__ __forceinline__ void operator()(const f32x4 (&acc)[2][2][4][2], const Unit& u, int wr, int wc, int fr, int fq) const {
        const int pn = u.pn; const bool rope = (u.e == 0 && pn >= 2);
        f32x4 ppv[2][4];
#pragma unroll
        for (int ai = 0; ai < 2; ++ai)
#pragma unroll
            for (int m = 0; m < 4; ++m) ppv[ai][m] = *(const f32x4*)((const char*)SSQ_Q + (size_t)u.e * (WS_SSQKV - WS_SSQQ) + (size_t)(u.pm * 256 + ai * HALF + wr * 64 + m * 16 + fr) * 16);
#pragma unroll
        for (int ai = 0; ai < 2; ++ai) {
            f32x4 csv[4][2];
            if (rope) {
#pragma unroll
                for (int m = 0; m < 4; ++m) { const int row = u.pm * 256 + ai * HALF + wr * 64 + m * 16 + fr;
                    csv[m][0] = *(const f32x4*)(CS + (size_t)row * 16 + 4 * fq); csv[m][1] = *(const f32x4*)(CS + (size_t)row * 16 + 4 * fq + 2); } }
#pragma unroll
            for (int m = 0; m < 4; ++m) {
                const int row = u.pm * 256 + ai * HALF + wr * 64 + m * 16 + fr;
                const f32x4 pp = ppv[ai][m];
                const float ss = (pp[0] + pp[1]) + (pp[2] + pp[3]);
                const float rs = u.e ? rsqrtf(ss * (1.f / 128.f) + EPS) : rsqrtf(ss * (1.f / 256.f) + EPS) * C2M;
#pragma unroll
                for (int bj = 0; bj < 2; ++bj) {
                    f32x4 v0 = acc[ai][bj][m][0] * rs, v1 = acc[ai][bj][m][1] * rs;
                    const int n = pn * 256 + bj * HALF + wc * 32 + 8 * fq;
                    if (u.e == 0) {
                        if (pn < 2) { *(v4u*)(QM + (size_t)row * 768 + (n >> 6) * 96 + (n & 63)) = pack8(v0, v1); }
                        else { const int h = 4 * bj + wc;
                            const f32x4 cs0 = csv[m][0], cs1 = csv[m][1];
                            const float c[4] = {cs0[0], cs0[2], cs1[0], cs1[2]}, s[4] = {cs0[1], cs0[3], cs1[1], cs1[3]};
                            f32x4 o1, o2;
#pragma unroll
                            for (int i = 0; i < 4; ++i) { o1[i] = v0[i] * c[i] - v1[i] * s[i]; o2[i] = v0[i] * s[i] + v1[i] * c[i]; }
                            *(v4u*)(QM + (size_t)row * 768 + h * 96 + 64 + 8 * fq) = pack8(o1, o2); }
                    } else {
                        if (pn < 2) *(v4u*)(KN + (size_t)row * 512 + n) = pack8(v0, v1);
                        else *(v4u*)(VM + (size_t)row * 512 + (n - 512)) = pack8(v0, v1);
                    }
                }
            } }
    }
};

__device__ __forceinline__ void unpack8(const v4u& g, float (&f)[8]) { f[0] = bf2f(g.x & 0xffffu); f[1] = bf2f(g.x >> 16); f[2] = bf2f(g.y & 0xffffu); f[3] = bf2f(g.y >> 16); f[4] = bf2f(g.z & 0xffffu); f[5] = bf2f(g.z >> 16); f[6] = bf2f(g.w & 0xffffu); f[7] = bf2f(g.w >> 16); }
struct EpiUp { bf16* MG; const bf16* PROJ;
    static constexpr bool HAS_MID = true;
    __device__ __forceinline__ void mid(f32x4 (&acc)[2][2][4][2], const Unit& u, int wr, int wc, int fr, int fq) const {
        int row0 = u.pm * 256 + wr * 64 + fr; asm volatile("" : "+v"(row0));
#pragma unroll
        for (int ai = 0; ai < 2; ++ai) {
            v4u ga[4][2];
#pragma unroll
            for (int m = 0; m < 4; ++m)
#pragma unroll
                for (int bj = 0; bj < 2; ++bj) ga[m][bj] = *(const v4u*)(PROJ + (size_t)(row0 + ai * HALF + m * 16) * NPROJ + 2048 + (u.pn * 2 + bj) * 256 + wc * 32 + 8 * fq);
#pragma unroll
            for (int m = 0; m < 4; ++m) {
#pragma unroll
                for (int bj = 0; bj < 2; ++bj) { float fa[8]; unpack8(ga[m][bj], fa);
#pragma unroll
                    for (int i = 0; i < 4; ++i) { acc[ai][bj][m][0][i] *= fa[i]; acc[ai][bj][m][1][i] *= fa[4 + i]; } } }
#pragma unroll
            for (int m = 0; m < 4; ++m) asm volatile("" : "+v"(acc[ai][0][m][0]), "+v"(acc[ai][0][m][1]), "+v"(acc[ai][1][m][0]), "+v"(acc[ai][1][m][1]) :: "memory"); }
    }
    __device__ __forceinline__ void operator()(const f32x4 (&acc)[2][2][4][2], const Unit& u, int wr, int wc, int fr, int fq) const {
#pragma unroll
        for (int ai = 0; ai < 2; ++ai)
#pragma unroll
            for (int m = 0; m < 4; ++m) { const int row = u.pm * 256 + ai * HALF + wr * 64 + m * 16 + fr;
#pragma unroll
                for (int bj = 0; bj < 2; ++bj) { const int c = u.pn * 256 + bj * HALF + wc * 32 + 8 * fq;
                    const v4u gb = *(const v4u*)(PROJ + (size_t)row * NPROJ + 2048 + 128 + (u.pn * 2 + bj) * 256 + wc * 32 + 8 * fq); float fb[8]; unpack8(gb, fb);
                    f32x4 v0 = acc[ai][bj][m][0], v1 = acc[ai][bj][m][1];
#pragma unroll
                    for (int i = 0; i < 4; ++i) { v0[i] *= fb[i]; v1[i] *= fb[4 + i]; }
                    *(v4u*)(MG + (size_t)row * DM + c) = pack8(v0, v1); } }
    }
};
struct EpiOut { const float* X; bf16* X1; float* SSQ2;
    __device__ __forceinline__ void operator()(const f32x4 (&acc)[2][2][4][2], const Unit& u, int wr, int wc, int fr, int fq) const {
#pragma unroll
        for (int ai = 0; ai < 2; ++ai)
#pragma unroll
            for (int m = 0; m < 4; ++m) { const int row = u.pm * 256 + ai * HALF + wr * 64 + m * 16 + fr; float ssq = 0.f;
#pragma unroll
                for (int bj = 0; bj < 2; ++bj) { const int c = u.pn * 256 + bj * HALF + wc * 32 + 8 * fq;
                    const f32x4 x0 = *(const f32x4*)(X + (size_t)row * DM + c), x1 = *(const f32x4*)(X + (size_t)row * DM + c + 4);
                    const f32x4 v0 = acc[ai][bj][m][0] + x0, v1 = acc[ai][bj][m][1] + x1;
                    ssq += dot4(v0) + dot4(v1);
                    *(v4u*)(X1 + (size_t)row * DM + c) = pack8(v0, v1); }
                ssq += __shfl_xor(ssq, 16); ssq += __shfl_xor(ssq, 32); if (fq == 0) SSQ2[(size_t)row * 16 + u.pn * 4 + wc] = ssq; }
    }
};

struct ExpertTab { LAS int* tab; };
struct OrderExpert { LAS const int* tab; int nN, G, c, base, win;
    __device__ __forceinline__ bool next(int i, Unit& u) const {
        if (i >= win) return false;
        const int x = c & 7; int idx = (base + i) * (G >> 3) + (c >> 3);
#pragma unroll
        for (int j = 0; j < 4; ++j) { const int e = x + 8 * j; const int nt = tab[33 + e] - tab[32 + e]; const int n = nt * nN;
            if (idx < n) { u.e = e; u.rt = idx / nN; u.pn = idx % nN; u.pm = tab[32 + e] + u.rt; u.ord = i; return true; } idx -= n; }
        return false; } };
constexpr int TOKT_OFF = RING_BYTES, TOKT_UNITS = 16;
template <bool LDSTOK> struct ProbExp1 {
    static constexpr bool FP8 = true;
    const unsigned char* XQ; const unsigned char* W1T8; const int* TOKL; LAS const int* tab; LAS const unsigned short* tokT; int K, ldb;
    __device__ __forceinline__ const char* a_base() const { return (const char*)XQ; }
    __device__ __forceinline__ int tok_g(const Unit& u, int r) const { const int slot = u.rt * 256 + r, last = tab[u.e] - 1; return TOKL[u.e * NTOK + (slot < last ? slot : last)]; }
    __device__ __forceinline__ int tok(const Unit& u, int r) const { if constexpr (LDSTOK) return (int)tokT[u.ord * 256 + r]; else return tok_g(u, r); }
    __device__ __forceinline__ unsigned a_off(const Unit& u, int r) const { return (unsigned)tok(u, r) * 1024u; }
    __device__ __forceinline__ const char* b_base(const Unit& u) const { return (const char*)(W1T8 + ((size_t)u.e * 2048 + (size_t)u.pn * 256) * 1024); }
};
__device__ __forceinline__ v4u pair16(const v2u& wa, const v2u& wb) {
    const auto r0 = __builtin_amdgcn_permlane16_swap(wa.x, wb.x, false, false), r1 = __builtin_amdgcn_permlane16_swap(wa.y, wb.y, false, false);
    return (v4u){r0[0], r1[0], r0[1], r1[1]};
}
struct EpiExp1 { unsigned char* HB; const float* B1; LAS float* tl;
    static constexpr bool HAS_PRE = true;
    __device__ __forceinline__ void pre(const Unit& u, int wid, int lane) const {
        if (wid == 7) __builtin_amdgcn_global_load_lds((const unsigned*)(B1 + (size_t)u.e * 2048 + (lane >> 5) * 1024 + u.pn * 128 + (lane & 31) * 4), (LAS unsigned*)(tl + (u.ord & 1) * 256), 16, 0, 0); }
    __device__ __forceinline__ void operator()(const f32x4 (&acc)[2][2][4][2], const Unit& u, int wr, int wc, int fr, int fq) const {
        const int j0 = u.pn * 128 + wc * 32 + 8 * fq;
        LAS const float* bt = tl + (u.ord & 1) * 256 + wc * 32 + 8 * fq;
        const f32x4 bg0 = *(LAS const f32x4*)bt, bg1 = *(LAS const f32x4*)(bt + 4), bl0 = *(LAS const f32x4*)(bt + 128), bl1 = *(LAS const f32x4*)(bt + 132);
        constexpr float RS = 1.0f / W8_SCALE;
#pragma unroll
        for (int ai = 0; ai < 2; ++ai)
#pragma unroll
            for (int mp = 0; mp < 4; mp += 2) { v2u w[2];
#pragma unroll
                for (int mm = 0; mm < 2; ++mm) { const int m = mp + mm;
                    const f32x4 g0 = acc[ai][0][m][0] * RS + bg0, g1 = acc[ai][0][m][1] * RS + bg1, l0 = acc[ai][1][m][0] * RS + bl0, l1 = acc[ai][1][m][1] * RS + bl1;
                    f32x4 o0, o1;
#pragma unroll
                    for (int i = 0; i < 4; ++i) {
                        { const float g = fminf(g0[i], 7.f), l = fminf(fmaxf(l0[i], -7.f), 7.f); o0[i] = g * __builtin_amdgcn_rcpf(1.f + __builtin_amdgcn_exp2f(-1.702f * LOG2E * g)) * __builtin_fmaf(l, H8_SCALE, H8_SCALE); }
                        { const float g = fminf(g1[i], 7.f), l = fminf(fmaxf(l1[i], -7.f), 7.f); o1[i] = g * __builtin_amdgcn_rcpf(1.f + __builtin_amdgcn_exp2f(-1.702f * LOG2E * g)) * __builtin_fmaf(l, H8_SCALE, H8_SCALE); } }
                    w[mm].x = pk4_fp8(o0[0], o0[1], o0[2], o0[3]); w[mm].y = pk4_fp8(o1[0], o1[1], o1[2], o1[3]); }
                const int r = ai * HALF + wr * 64 + (mp + (fq & 1)) * 16 + fr;
                *(v4u*)(HB + (size_t)(u.pm * 256 + r) * 1024 + j0 - 8 * (fq & 1)) = pair16(w[0], w[1]); }
    }
};
struct ProbExp2 { static constexpr bool FP8 = true; const unsigned char* HB; const unsigned char* W2T8; int K, ldb;
    __device__ __forceinline__ const char* a_base() const { return (const char*)HB; }
    __device__ __forceinline__ unsigned a_off(const Unit& u, int r) const { return (unsigned)(u.pm * 256 + r) * 1024u; }
    __device__ __forceinline__ const char* b_base(const Unit& u) const { return (const char*)(W2T8 + ((size_t)u.e * 1024 + (size_t)u.pn * 256) * 1024); }
};
struct EpiExp2 { unsigned char* YB; const float* B2; LAS float* tl;
    static constexpr bool HAS_PRE = true;
    __device__ __forceinline__ void pre(const Unit& u, int wid, int lane) const {
        if (wid == 7) __builtin_amdgcn_global_load_lds((const unsigned*)(B2 + (size_t)u.e * 1024 + u.pn * 256 + lane * 4), (LAS unsigned*)(tl + (u.ord & 1) * 256), 16, 0, 0); }
    __device__ __forceinline__ void operator()(const f32x4 (&acc)[2][2][4][2], const Unit& u, int wr, int wc, int fr, int fq) const {
#pragma unroll
        for (int bj = 0; bj < 2; ++bj) { const int c = u.pn * 256 + bj * HALF + wc * 32 + 8 * fq;
            LAS const float* bt = tl + (u.ord & 1) * 256 + bj * HALF + wc * 32 + 8 * fq;
            const f32x4 b0 = *(LAS const f32x4*)bt * Y8_SCALE, b1 = *(LAS const f32x4*)(bt + 4) * Y8_SCALE;
#pragma unroll
            for (int ai = 0; ai < 2; ++ai)
#pragma unroll
                for (int mp = 0; mp < 4; mp += 2) { v2u w[2];
                    constexpr float RS = Y8_SCALE / (W8_SCALE * H8_SCALE);
#pragma unroll
                    for (int mm = 0; mm < 2; ++mm) { const f32x4 y0 = acc[ai][bj][mp + mm][0] * RS + b0, y1 = acc[ai][bj][mp + mm][1] * RS + b1;
                        w[mm].x = pk4_fp8(y0[0], y0[1], y0[2], y0[3]); w[mm].y = pk4_fp8(y1[0], y1[1], y1[2], y1[3]); }
                    const int r = ai * HALF + wr * 64 + (mp + (fq & 1)) * 16 + fr;
                    *(v4u*)(YB + (size_t)(u.pm * 256 + r) * 1024 + c - 8 * (fq & 1)) = pair16(w[0], w[1]); } }
    }
};
__device__ __forceinline__ void build_expert_tab(const gu32* ctl, LAS int* tab, int tid) {
    if (tid < 64) {
        const int cnt = (tid < NE) ? (int)ctl[CW_GCNT + tid] : 0; const int tiles = (cnt + 255) >> 8;
        int inc = tiles;
#pragma unroll
        for (int o = 1; o < 32; o <<= 1) { const int up = __shfl_up(inc, o); if ((tid & 63) >= o) inc += up; }
        if (tid < NE) { tab[tid] = cnt; tab[32 + tid] = inc - tiles; }
        if (tid == NE - 1) tab[64] = inc; }
    LDS_WAIT(); __syncthreads();
}

namespace att {
using bf16x8 = __attribute__((ext_vector_type(8))) short;
using s16x4 = __attribute__((ext_vector_type(4))) short;
using f32x16 = __attribute__((ext_vector_type(16))) float;
typedef short v4i16_t __attribute__((ext_vector_type(4)));
typedef LAS const char* lds_cptr;
__constant__ unsigned char T5_BUCKET[128] = {0, 1, 2, 3, 4, 5, 6, 7, 8, 9, 10, 11, 12, 13, 14, 15, 16, 16, 16, 17, 17, 18, 18, 18, 19, 19, 19, 20, 20, 20, 20, 21, 21, 21, 21, 22, 22, 22, 22, 22, 23, 23, 23, 23, 23, 23, 24, 24, 24, 24, 24, 24, 25, 25, 25, 25, 25, 25, 25, 26, 26, 26, 26, 26, 26, 26, 26, 27, 27, 27, 27, 27, 27, 27, 27, 27, 27, 28, 28, 28, 28, 28, 28, 28, 28, 28, 28, 29, 29, 29, 29, 29, 29, 29, 29, 29, 29, 29, 29, 30, 30, 30, 30, 30, 30, 30, 30, 30, 30, 30, 30, 30, 30, 31, 31, 31, 31, 31, 31, 31, 31, 31, 31, 31, 31, 31, 31, 31};
constexpr int NS = 5;
constexpr int WSF_OFF = NS * 24576, BIAS_OFF = WSF_OFF + 8 * 256, ATT_LDS = BIAS_OFF + 512;
static_assert(ATT_LDS <= RING_BYTES, "attention LDS");
#define ASBAR() __builtin_amdgcn_sched_barrier(0)
#define AMFMA(a, b, c) __builtin_amdgcn_mfma_f32_32x32x16_bf16(a, b, c, 0, 0, 0)
#define ABAR_L() asm volatile("s_waitcnt lgkmcnt(0)\n\ts_barrier" ::: "memory")
#define ABAR_VL() asm volatile("s_waitcnt vmcnt(0) lgkmcnt(0)\n\ts_barrier" ::: "memory")
__device__ __forceinline__ int crow(int r, int hi) { return (r & 3) + 8 * (r >> 2) + 4 * hi; }
__device__ __forceinline__ void glds16(const void* gsrc, unsigned lds_dst) { unsigned keep;
    asm volatile("s_mov_b32 %0, m0\n\ts_mov_b32 m0, %2\n\ts_nop 0\n\tglobal_load_lds_dwordx4 %1, off\n\ts_mov_b32 m0, %0" : "=&s"(keep) : "v"(gsrc), "s"(lds_dst) : "memory"); }
__device__ __forceinline__ void glds16_s(const char* sbase, unsigned voff, unsigned lds_dst) { unsigned keep;
    asm volatile("s_mov_b32 %0, m0\n\ts_mov_b32 m0, %3\n\ts_nop 0\n\tglobal_load_lds_dwordx4 %1, %2\n\ts_mov_b32 m0, %0" : "=&s"(keep) : "v"(voff), "s"(sbase), "s"(lds_dst) : "memory"); }
__device__ __forceinline__ float max3f(float a, float b, float c) { return __builtin_fmaxf(__builtin_fmaxf(a, b), c); }
__device__ __forceinline__ s16x4 vtr(lds_cptr p) { return __builtin_bit_cast(s16x4, __builtin_amdgcn_ds_read_tr16_b64_v4i16((LAS v4i16_t*)p)); }
typedef float f32x2_t __attribute__((ext_vector_type(2))); typedef __bf16 bf16x2_t __attribute__((ext_vector_type(2)));
__device__ __forceinline__ unsigned cvtpk_s(float lo, float hi) { f32x2_t v = {lo, hi}; bf16x2_t b = __builtin_convertvector(v, bf16x2_t); return __builtin_bit_cast(unsigned, b); }

struct ConvArgs { const float* w1; const float* w2; const float* nf; unsigned char* W1T8; unsigned char* W2T8; int stride; int mode; };
struct ConvState { int next, ne, nr, ce, cr, pending; };
constexpr int CONV_PER_E = 3072, CONV_NITEM = 32 * CONV_PER_E;
__device__ __forceinline__ void conv_issue(const ConvArgs& C, int e, int r, unsigned stage, int lane) {
    const bool is1 = r < 2048; const int r2 = is1 ? r : r - 2048, kb = r2 & 63, nb = r2 >> 6;
    const int pitch = is1 ? 2048 : 1024;
    const int col0 = is1 ? (((nb >> 1) & 1) * 1024 + (nb >> 2) * 128 + (nb & 1) * 64) : 64 * nb;
    const float* src = (is1 ? C.w1 + (size_t)e * 1024 * 2048 : C.w2 + (size_t)e * 1024 * 1024) + (size_t)(16 * kb + (lane >> 4)) * pitch + col0 + 4 * (lane & 15);
#pragma unroll
    for (int q = 0; q < 4; ++q) glds16(src + (size_t)(4 * q) * pitch, (unsigned)__builtin_amdgcn_readfirstlane(stage + q * 1024));
}
__device__ __forceinline__ void conv_finish(const ConvArgs& C, int e, int r, LAS const float* stg, int lane) {
    const bool is1 = r < 2048; const int r2 = is1 ? r : r - 2048, kb = r2 & 63, nb = r2 >> 6, k0 = 16 * kb;
    float v[16];
#ifdef PROBE_ATT_MODE
    if (C.mode == 4) return;
    if (C.mode == 6) {
#pragma unroll
        for (int k = 0; k < 16; ++k) v[k] = (float)(lane + k);
    } else
#endif
    {
#pragma unroll
    for (int k = 0; k < 16; ++k) v[k] = stg[k * 64 + lane];
    }
#ifdef PROBE_ATT_MODE
    if (C.mode == 5) { asm volatile("" :: "v"(v[0]), "v"(v[1]), "v"(v[2]), "v"(v[3]), "v"(v[4]), "v"(v[5]), "v"(v[6]), "v"(v[7]), "v"(v[8]), "v"(v[9]), "v"(v[10]), "v"(v[11]), "v"(v[12]), "v"(v[13]), "v"(v[14]), "v"(v[15])); return; }
#endif
    if (is1) {
        const __attribute__((address_space(4))) float* nfc = (const __attribute__((address_space(4))) float*)(uintptr_t)C.nf + __builtin_amdgcn_readfirstlane(k0);
#pragma unroll
        for (int k = 0; k < 16; ++k) v[k] *= nfc[k] * W8_SCALE;
    } else {
#pragma unroll
        for (int k = 0; k < 16; ++k) v[k] *= W8_SCALE;
    }
    v4u o; o.x = pk4_fp8(v[0], v[1], v[2], v[3]); o.y = pk4_fp8(v[4], v[5], v[6], v[7]); o.z = pk4_fp8(v[8], v[9], v[10], v[11]); o.w = pk4_fp8(v[12], v[13], v[14], v[15]);
    unsigned char* dst = (is1 ? C.W1T8 + ((size_t)e * 2048 + 64 * nb + lane) * 1024 : C.W2T8 + ((size_t)e * 1024 + 64 * nb + lane) * 1024) + k0;
    *(v4u*)dst = o;
}
struct AttnP {
    const bf16* Q; int qp; const bf16* K; int kp; const bf16* K2; int k2p; const bf16* V; int vp; bf16* O; int op;
    const float* rel_bias; int bh;
};

template <int DQK, int DV, bool BIAS>
__device__ __forceinline__ void attn_unit(const AttnP& T, int qb, LAS unsigned char* shm, const ConvArgs& CV, ConvState& cs) {
    constexpr int NKP = DQK / 8, NVP = DV / 8, NP = NKP + NVP, SLOTB = NP * 1024, KS = DQK / 16, DB = DV / 32, VOFF = NKP * 1024;
    static_assert(SLOTB <= 24576, "slot size");
    constexpr float THR = 8.0f;
    int tid = threadIdx.x; asm volatile("" : "+v"(tid));
    const int lane = tid & 63, r32 = lane & 31, hi = lane >> 5; const int wid = __builtin_amdgcn_readfirstlane(tid >> 6);
    const int half = wid >> 2;
    const int q0 = qb * 256, NT = (q0 + 256) / 64;
    const unsigned lds0 = (unsigned)(uintptr_t)shm;
    LAS float* wsf = (LAS float*)(shm + WSF_OFF) + wid * 64;
    LAS float* biasL = (LAS float*)(shm + BIAS_OFF);
    const char* dsb[3]; unsigned dvo[3]; int dstride[3];
#pragma unroll
    for (int pi_ = 0; pi_ < 3; ++pi_) { const int p_ = wid + 8 * pi_; dsb[pi_] = (const char*)T.K; dvo[pi_] = 0u; dstride[pi_] = 0;
        if (p_ < NKP) { if (DQK == 96 && p_ >= 8) { dsb[pi_] = (const char*)(T.K2 + (p_ - 8) * 8); dvo[pi_] = (unsigned)(lane * T.k2p) * 2u; dstride[pi_] = 128 * T.k2p; } else { dsb[pi_] = (const char*)(T.K + p_ * 8); dvo[pi_] = (unsigned)(lane * T.kp) * 2u; dstride[pi_] = 128 * T.kp; } }
        else if (p_ < NP) { const int pv_ = p_ - NKP; dsb[pi_] = (const char*)(T.V + (size_t)(16 * (pv_ & 3)) * T.vp + (pv_ >> 2) * 32); dvo[pi_] = (unsigned)((lane >> 2) * T.vp + (lane & 3) * 8) * 2u; dstride[pi_] = 128 * T.vp; }
        asm volatile("" : "+v"(dvo[pi_])); }
    const unsigned ddst0 = lds0 + wid * 1024;
#define DMA_NEXT(slotoff) do { _Pragma("unroll") for (int pi_ = 0; pi_ < 3; ++pi_) { if (pi_ < 2 || NP == 24 || wid < NP - 16) { \
        glds16_s(dsb[pi_], dvo[pi_], (unsigned)__builtin_amdgcn_readfirstlane(ddst0 + (slotoff) + pi_ * 8192)); dsb[pi_] += dstride[pi_]; } } } while (0)
    DMA_NEXT(0); DMA_NEXT(SLOTB); DMA_NEXT(2 * SLOTB);
    bf16x8 qr[KS];
    { const bf16* Qw = T.Q + (size_t)(q0 + wid * 32 + r32) * T.qp + hi * 8;
#pragma unroll
      for (int ks = 0; ks < KS; ++ks) qr[ks] = *reinterpret_cast<const bf16x8*>(Qw + ks * 16);
#pragma unroll
      for (int ks = 0; ks < KS; ++ks) asm volatile("" : "+v"(qr[ks])); }
    if (BIAS) { if (tid < 128) { const float b31 = T.rel_bias[31 * 4 + T.bh]; biasL[tid] = (T.rel_bias[(int)T5_BUCKET[tid] * 4 + T.bh] - b31) * LOG2E; } }
    float mhat = 0.f, l_reg = 0.f;
    f32x16 o[DB];
#pragma unroll
    for (int d = 0; d < DB; ++d) o[d] = f32x16{};
    f32x16 negm = f32x16{}; asm volatile("" : "+v"(negm));
    typedef unsigned u32x4 __attribute__((ext_vector_type(4)));
    u32x4 pw0 = {0u, 0u, 0u, 0u}, pw1 = pw0, pw2 = pw0, pw3 = pw0;
    const int qrel = wid * 32 + r32;
    const lds_cptr shm3 = (lds_cptr)shm;
    const lds_cptr kp0 = shm3 + hi * 1024 + r32 * 16;
    const lds_cptr vp0 = shm3 + VOFF + ((lane >> 4) & 1) * 32 + (lane & 3) * 8 + (4 * hi + ((lane & 15) >> 2)) * 64;
    ABAR_VL();
    bf16x8 kf[2 * KS];
#define KLOAD(slotoff) do { const lds_cptr kb_ = kp0 + (slotoff); _Pragma("unroll") for (int ks = 0; ks < KS; ++ks) { kf[2 * ks] = *(const LAS bf16x8*)(kb_ + ks * 2048); kf[2 * ks + 1] = *(const LAS bf16x8*)(kb_ + ks * 2048 + 512); } } while (0)
    KLOAD(0);
    if (half == 1) ABAR_L();
    s16x4 vl[2][4], vh[2][4];
#define VRD(buf, d0, slotoff) do { const lds_cptr vp_ = vp0 + (slotoff) + (d0) * 4096; _Pragma("unroll") for (int ks = 0; ks < 4; ++ks) { vl[buf][ks] = vtr(vp_ + ks * 1024); vh[buf][ks] = vtr(vp_ + ks * 1024 + 512); } } while (0)
#define VFR(buf, k) ((bf16x8){vl[buf][k][0], vl[buf][k][1], vl[buf][k][2], vl[buf][k][3], vh[buf][k][0], vh[buf][k][1], vh[buf][k][2], vh[buf][k][3]})
#define PV_BLK(buf, d0) do { o[d0] = AMFMA(__builtin_bit_cast(bf16x8, pw0), VFR(buf, 0), o[d0]); o[d0] = AMFMA(__builtin_bit_cast(bf16x8, pw1), VFR(buf, 1), o[d0]); \
        o[d0] = AMFMA(__builtin_bit_cast(bf16x8, pw2), VFR(buf, 2), o[d0]); o[d0] = AMFMA(__builtin_bit_cast(bf16x8, pw3), VFR(buf, 3), o[d0]); } while (0)
#define SGB_MFMA_DS(nm, nd) do { __builtin_amdgcn_sched_group_barrier(0x8, nm, 0); __builtin_amdgcn_sched_group_barrier(0x100, nd, 0); } while (0)
#define PV_ALL(slotoff) do { _Pragma("unroll") for (int d0 = 0; d0 < DB; ++d0) { if (d0 + 1 < DB) VRD((d0 + 1) & 1, d0 + 1, slotoff); PV_BLK(d0 & 1, d0); \
        if (d0 + 1 < DB) { SGB_MFMA_DS(1, 2); SGB_MFMA_DS(1, 2); SGB_MFMA_DS(1, 2); SGB_MFMA_DS(1, 2); } ASBAR(); } } while (0)
    int sl_prev = 4 * SLOTB, slot_t = 0, sl_d = 3 * SLOTB;
    for (int t = 0; t < NT; ++t) {
        ASBAR();
        __builtin_amdgcn_s_setprio(1);
        const bool more = (t + 3 < NT);
        if (more) DMA_NEXT(sl_d);
        ASBAR();
        f32x16 s0, s1;
#define QK_ALL() do { _Pragma("unroll") for (int ks = 0; ks < KS; ++ks) { \
            if (ks == 0) { s0 = AMFMA(kf[0], qr[0], negm); s1 = AMFMA(kf[1], qr[0], negm); } \
            else { s0 = AMFMA(kf[2 * ks], qr[ks], s0); s1 = AMFMA(kf[2 * ks + 1], qr[ks], s1); } } } while (0)
        if (t > 0) {
            VRD(0, 0, sl_prev); QK_ALL();
            SGB_MFMA_DS(1, 1); SGB_MFMA_DS(1, 1); SGB_MFMA_DS(1, 1); SGB_MFMA_DS(1, 1); SGB_MFMA_DS(1, 1); SGB_MFMA_DS(1, 1); SGB_MFMA_DS(1, 1); SGB_MFMA_DS(1, 1);
            __builtin_amdgcn_sched_group_barrier(0x8, 2 * KS - 8, 0);
        } else { QK_ALL(); }
#undef QK_ALL
        ASBAR();
        if (t > 0) PV_ALL(sl_prev);
        __builtin_amdgcn_s_setprio(0);
#if defined(ATT_NOP_M)
        asm volatile("s_nop 15\n\ts_nop 15\n\ts_nop 15\n\ts_nop 15\n\ts_nop 15\n\ts_nop 15\n\ts_nop 15\n\ts_nop 15\n\ts_nop 15\n\ts_nop 15\n\ts_nop 15\n\ts_nop 15\n\ts_nop 15\n\ts_nop 15\n\ts_nop 15\n\ts_nop 15" ::: "memory");
#endif
        ASBAR();
        if (more) { if (NP == 24 || wid < (NP - 16)) asm volatile("s_waitcnt vmcnt(3) lgkmcnt(0)\n\ts_barrier" ::: "memory"); else asm volatile("s_waitcnt vmcnt(2) lgkmcnt(0)\n\ts_barrier" ::: "memory"); }
        else ABAR_VL();
        ASBAR();
        if (t + 1 < NT) KLOAD((slot_t == 4 * SLOTB) ? 0 : slot_t + SLOTB);
        ASBAR();
        { const int jb = t - (NT - 4);
          if (jb >= 0) { const int kb_ = 64 * jb + 4 * hi;
#pragma unroll
              for (int r = 0; r < 16; ++r) { const int kv = kb_ + (r & 3) + 8 * (r >> 2); if (kv > qrel) s0[r] = -INFINITY; if (kv + 32 > qrel) s1[r] = -INFINITY; } }
          if (BIAS) { if (q0 + wid * 32 - (64 * t + 63) < 113) {
              const int db = q0 + qrel - 64 * t - 4 * hi;
#pragma unroll
              for (int r = 0; r < 16; ++r) { int d0_ = db - ((r & 3) + 8 * (r >> 2)); int d1_ = d0_ - 32;
                  d0_ = d0_ < 0 ? 0 : (d0_ > 127 ? 127 : d0_); d1_ = d1_ < 0 ? 0 : (d1_ > 127 ? 127 : d1_);
                  s0[r] += biasL[d0_]; s1[r] += biasL[d1_]; } } }
          float a_ = max3f(s0[0], s0[1], s1[0]), b_ = max3f(s0[2], s0[3], s1[1]); a_ = max3f(a_, s1[2], s1[3]);
#pragma unroll
          for (int r = 4; r < 16; r += 4) { a_ = max3f(a_, s0[r], s0[r + 1]); b_ = max3f(b_, s0[r + 2], s0[r + 3]); a_ = max3f(a_, s1[r], s1[r + 1]); b_ = max3f(b_, s1[r + 2], s1[r + 3]); }
          float rm = __builtin_fmaxf(a_, b_);
          if (t == 0 || __any(rm > THR)) {
              { auto rr = __builtin_amdgcn_permlane32_swap(__float_as_uint(rm), __float_as_uint(rm), false, false); rm = __builtin_fmaxf(__uint_as_float(rr[0]), __uint_as_float(rr[1])); }
              const float dl = (t == 0) ? rm : __builtin_fmaxf(rm, 0.f);
              mhat += dl;
#pragma unroll
              for (int r = 0; r < 16; ++r) { s0[r] -= dl; s1[r] -= dl; }
#pragma unroll
              for (int r = 0; r < 16; ++r) negm[r] = -mhat;
              asm volatile("" : "+v"(negm));
              if (t > 0) { const float f = __builtin_amdgcn_exp2f(-dl); l_reg *= f; if (hi == 0) wsf[r32] = f;
                  LDS_WAIT();
                  float fr_[16];
#pragma unroll
                  for (int r = 0; r < 16; ++r) fr_[r] = wsf[crow(r, hi)];
#pragma unroll
                  for (int d = 0; d < DB; ++d)
#pragma unroll
                      for (int r = 0; r < 16; ++r) o[d][r] *= fr_[r];
              }
          }
#if defined(ATT_DUP_V)
          { float sa_ = 0.f;
#pragma unroll
            for (int r = 0; r < 16; ++r) { float x_ = s0[r], y_ = s1[r]; asm volatile("" : "+v"(x_), "+v"(y_)); x_ = __builtin_amdgcn_exp2f(x_); y_ = __builtin_amdgcn_exp2f(y_); sa_ += x_ + y_; unsigned w_ = cvtpk_s(x_, y_); asm volatile("" :: "v"(w_)); }
            asm volatile("" :: "v"(sa_)); }
#endif
#pragma unroll
          for (int r = 0; r < 16; ++r) { s0[r] = __builtin_amdgcn_exp2f(s0[r]); s1[r] = __builtin_amdgcn_exp2f(s1[r]); }
          { float one_ = 1.0f; asm volatile("" : "+v"(one_)); float a0_ = 0.f, a1_ = 0.f;
#pragma unroll
            for (int r = 0; r < 16; ++r) { a0_ = a0_ + s0[r]; a1_ = __builtin_fmaf(s1[r], one_, a1_); }
            l_reg += a0_ + a1_; }
          pw0 = (u32x4){cvtpk_s(s0[0], s0[1]), cvtpk_s(s0[2], s0[3]), cvtpk_s(s0[4], s0[5]), cvtpk_s(s0[6], s0[7])};
          pw1 = (u32x4){cvtpk_s(s0[8], s0[9]), cvtpk_s(s0[10], s0[11]), cvtpk_s(s0[12], s0[13]), cvtpk_s(s0[14], s0[15])};
          pw2 = (u32x4){cvtpk_s(s1[0], s1[1]), cvtpk_s(s1[2], s1[3]), cvtpk_s(s1[4], s1[5]), cvtpk_s(s1[6], s1[7])};
          pw3 = (u32x4){cvtpk_s(s1[8], s1[9]), cvtpk_s(s1[10], s1[11]), cvtpk_s(s1[12], s1[13]), cvtpk_s(s1[14], s1[15])};
        }
        if ((t & 3) == 0) {
            LAS const float* stg_ = (LAS const float*)(shm + CONV_OFF + wid * 4096);
            if (cs.pending) { conv_finish(CV, cs.ce, cs.cr, stg_, lane); cs.pending = 0; }
            if (cs.next < CONV_NITEM) { LDS_WAIT(); conv_issue(CV, cs.ne, cs.nr, lds0 + CONV_OFF + wid * 4096, lane); cs.ce = cs.ne; cs.cr = cs.nr; cs.pending = 1;
                cs.next += CV.stride; cs.nr += CV.stride; while (cs.nr >= CONV_PER_E) { cs.nr -= CONV_PER_E; ++cs.ne; } }
        }
#if defined(ATT_NOP_V)
        asm volatile("s_nop 15\n\ts_nop 15\n\ts_nop 15\n\ts_nop 15\n\ts_nop 15\n\ts_nop 15\n\ts_nop 15\n\ts_nop 15\n\ts_nop 15\n\ts_nop 15\n\ts_nop 15\n\ts_nop 15\n\ts_nop 15\n\ts_nop 15\n\ts_nop 15\n\ts_nop 15" ::: "memory");
#endif
        ASBAR();
        ABAR_L();
        ASBAR();
        sl_prev = slot_t; slot_t = (slot_t == 4 * SLOTB) ? 0 : slot_t + SLOTB; sl_d = (sl_d == 4 * SLOTB) ? 0 : sl_d + SLOTB;
    }
    if (half == 0) ABAR_L();
    VRD(0, 0, sl_prev); PV_ALL(sl_prev);
    { auto rr = __builtin_amdgcn_permlane32_swap(__float_as_uint(l_reg), __float_as_uint(l_reg), false, false); l_reg = __uint_as_float(rr[0]) + __uint_as_float(rr[1]); }
    if (hi == 0) wsf[32 + r32] = l_reg;
    LDS_WAIT();
    { const int kbusy = sl_prev / SLOTB, pr = wid >> 1, fs = pr + (pr >= kbusy ? 1 : 0);
      LAS unsigned short* stg = (LAS unsigned short*)(shm + fs * SLOTB + (wid & 1) * (32 * DV * 2));
#pragma unroll
      for (int r = 0; r < 16; ++r) { const int orow = crow(r, hi); const float rl = __builtin_amdgcn_rcpf(wsf[32 + orow]);
#pragma unroll
          for (int d = 0; d < DB; ++d) stg[orow * DV + d * 32 + r32] = (unsigned short)f2bf(o[d][r] * rl); }
      LDS_WAIT();
      bf16* Ow = T.O + (size_t)(q0 + wid * 32) * T.op;
      constexpr int CPR = DV / 8, RPI = 64 / CPR;
#pragma unroll
      for (int i = 0; i < 32 / RPI; ++i) { const int row = i * RPI + lane / CPR, ch = lane % CPR;
          const v4u v = *(const LAS v4u*)(stg + row * DV + ch * 8); *(v4u*)(Ow + (size_t)row * T.op + ch * 8) = v; } }
    ABAR_L();
#undef DMA_NEXT
#undef PV_ALL
#undef SGB_MFMA_DS
#undef PV_BLK
#undef VFR
#undef VRD
#undef KLOAD
}
#undef ASBAR
#undef AMFMA
#undef ABAR_L
#undef ABAR_VL
}

__device__ __forceinline__ void p4_combine(const Args& a, int vcu, int G) {
    int tid_ = threadIdx.x; asm volatile("" : "+v"(tid_)); const int lane = tid_ & 63, wave = __builtin_amdgcn_readfirstlane(tid_ >> 6);
    const bf16* OD = (const bf16*)(a.ws + WS_OD); bf16* YC = (bf16*)(a.ws + WS_YC);
    const int gw = vcu * NWAVES + wave, NGW = G * NWAVES, sub = lane >> 4, l16 = lane & 15;
    const float dl0 = a.diff_lambda[lane], dl1 = a.diff_lambda[64 + lane], dl2 = a.diff_lambda[128 + lane], dl3 = a.diff_lambda[192 + lane];
    v4u w0[4], w1[4];
#define P4_LOAD(d0, d1, itb) do { _Pragma("unroll") for (int q = 0; q < 4; ++q) { const int it = (itb) + q * 4 * NGW; if (it < NTOK * 4) { const int row = it >> 2, h = it & 3; \
            d0[q] = *(const v4u*)(OD + (size_t)row * 1024 + (2 * h) * 128 + 8 * l16); d1[q] = *(const v4u*)(OD + (size_t)row * 1024 + (2 * h + 1) * 128 + 8 * l16); } else { d0[q] = (v4u){0u, 0u, 0u, 0u}; d1[q] = d0[q]; } } } while (0)
    int it0 = gw * 4 + sub;
    P4_LOAD(w0, w1, it0);
    const float lam = expf(wave_sum(dl0 * dl1)) - expf(wave_sum(dl2 * dl3)) + 0.2f;
    for (; it0 < NTOK * 4; it0 += 16 * NGW) {
        v4u n0[4], n1[4];
        P4_LOAD(n0, n1, it0 + 16 * NGW);
#pragma unroll
        for (int q = 0; q < 4; ++q) { const int it = it0 + q * 4 * NGW; const int row = it >> 2, h = it & 3;
            float fa[8], fb[8]; unpack8(w0[q], fa); unpack8(w1[q], fb);
            f32x4 y0, y1; float ss = 0.f;
#pragma unroll
            for (int k = 0; k < 4; ++k) { y0[k] = fa[k] - lam * fb[k]; y1[k] = fa[4 + k] - lam * fb[4 + k]; ss += y0[k] * y0[k] + y1[k] * y1[k]; }
            ss += __shfl_xor(ss, 1); ss += __shfl_xor(ss, 2); ss += __shfl_xor(ss, 4); ss += __shfl_xor(ss, 8);
            const float r = rsqrtf(ss * (1.f / 128.f) + EPS);
            if (it < NTOK * 4) *(v4u*)(YC + (size_t)row * 1024 + 512 + h * 128 + 8 * l16) = pack8(y0 * r, y1 * r); }
#pragma unroll
        for (int q = 0; q < 4; ++q) { w0[q] = n0[q]; w1[q] = n1[q]; }
    }
#undef P4_LOAD
}

__device__ __forceinline__ void p7_router(const Args& a, LAS unsigned char* lds, int vcu, int G) {
    int tid = threadIdx.x; asm volatile("" : "+v"(tid)); const int lane = tid & 63, wave = __builtin_amdgcn_readfirstlane(tid >> 6);
    typedef float f32x16 __attribute__((ext_vector_type(16)));
    const bf16* X1 = (const bf16*)(a.ws + WS_X1); const float* WRT = (const float*)(a.ws + WS_WR); const float* SSQ2 = (const float*)(a.ws + WS_SSQ2);
    int* TOKL = (int*)(a.ws + WS_TOKL); int* SEL = (int*)(a.ws + WS_SEL); float* WTS = (float*)(a.ws + WS_WTS);
    gu32* ctl = (gu32*)(a.ws + WS_CTL); unsigned char* XQ = a.ws + WS_XQ;
    LAS float* xs = (LAS float*)(lds + RING_OFF) + wave * (32 * 65);
    LAS float* part = (LAS float*)(lds + RING_OFF + 8 * 32 * 65 * 4);
    LAS int* lcnt = (LAS int*)(lds + RING_OFF + 8 * 32 * 65 * 4 + 8 * 32 * 33 * 4);
    LAS float* r2s = (LAS float*)(lcnt + 64);
    for (int blk = vcu; blk < NTOK / 64; blk += G) {
        const int tok0 = blk * 64;
        const int grp = wave >> 2, kq = wave & 3, i = lane & 31, h = lane >> 5;
        f32x16 acc = f32x16{};
        const bf16* xg = X1 + (size_t)(tok0 + grp * 32 + (lane >> 3)) * DM + kq * 256 + 8 * (lane & 7);
        const float* wg = WRT + (size_t)i * DM + kq * 256 + 4 * h;
        v4u xq[4]; f32x4 wv[8];
#pragma unroll
        for (int j = 0; j < 4; ++j) xq[j] = *(const v4u*)(xg + (size_t)(8 * j) * DM);
#pragma unroll
        for (int c = 0; c < 8; ++c) wv[c] = *(const f32x4*)(wg + 8 * c);
        if (tid < 64) { const int t = tok0 + tid; float ss = 0.f;
#pragma unroll
            for (int j = 0; j < 4; ++j) { const f32x4 p = *(const f32x4*)(SSQ2 + (size_t)t * 16 + 4 * j); ss += (p[0] + p[1]) + (p[2] + p[3]); }
            r2s[tid] = rsqrtf(ss * (1.f / DM) + EPS); }
        LDS_WAIT(); __syncthreads();
#pragma unroll
        for (int p = 0; p < 4; ++p) {
            v4u xn[4]; f32x4 wn[8];
            if (p < 3) {
#pragma unroll
                for (int j = 0; j < 4; ++j) xn[j] = *(const v4u*)(xg + (size_t)(8 * j) * DM + 64 * (p + 1));
#pragma unroll
                for (int c = 0; c < 8; ++c) wn[c] = *(const f32x4*)(wg + 64 * (p + 1) + 8 * c); }
#pragma unroll
            for (int j = 0; j < 4; ++j) { float xv[8]; unpack8(xq[j], xv);
                LAS float* d = xs + ((lane >> 3) + 8 * j) * 65 + 8 * (lane & 7);
#pragma unroll
                for (int i2 = 0; i2 < 8; ++i2) d[i2] = xv[i2];
                const int tl = grp * 32 + (lane >> 3) + 8 * j; const float rr = r2s[tl];
                v2u o8; o8.x = pk4_fp8(xv[0] * rr, xv[1] * rr, xv[2] * rr, xv[3] * rr); o8.y = pk4_fp8(xv[4] * rr, xv[5] * rr, xv[6] * rr, xv[7] * rr);
                *(v2u*)(XQ + (size_t)(tok0 + tl) * 1024 + kq * 256 + 64 * p + 8 * (lane & 7)) = o8; }
            LDS_WAIT();
#pragma unroll
            for (int c = 0; c < 8; ++c)
#pragma unroll
                for (int q = 0; q < 4; ++q) acc = __builtin_amdgcn_mfma_f32_32x32x2f32(xs[i * 65 + 8 * c + 4 * h + q], wv[c][q], acc, 0, 0, 0);
            LDS_WAIT();
            if (p < 3) {
#pragma unroll
                for (int j = 0; j < 4; ++j) xq[j] = xn[j];
#pragma unroll
                for (int c = 0; c < 8; ++c) wv[c] = wn[c]; }
        }
        if (tid < 32) lcnt[tid] = 0;
#pragma unroll
        for (int r = 0; r < 16; ++r) part[(wave * 32 + ((r & 3) + 8 * (r >> 2) + 4 * h)) * 33 + i] = acc[r];
        LDS_WAIT(); __syncthreads();
        if (tid < 64) {
            const int t = tok0 + tid, g2 = tid >> 5, ti = tid & 31;
            const float r2 = r2s[tid];
            float lg[NE];
#pragma unroll
            for (int e = 0; e < NE; ++e) { float s = 0.f;
#pragma unroll
                for (int k4 = 0; k4 < 4; ++k4) s += part[((g2 * 4 + k4) * 32 + ti) * 33 + e];
                lg[e] = s * r2 + a.b_router[e]; }
            float tv[4]; int te[4];
#pragma unroll
            for (int r = 0; r < 4; ++r) { float best = -3.0e38f; int bi = 0;
#pragma unroll
                for (int e = 0; e < NE; ++e) { if (lg[e] > best) { best = lg[e]; bi = e; } }
                tv[r] = best; te[r] = bi;
#pragma unroll
                for (int e = 0; e < NE; ++e) if (e == bi) lg[e] = -3.0e38f; }
            float ev[4], sum = 0.f;
#pragma unroll
            for (int r = 0; r < 4; ++r) { ev[r] = __expf(tv[r] - tv[0]); sum += ev[r]; }
            const float rs = 1.f / sum;
            int ls[4];
#pragma unroll
            for (int r = 0; r < 4; ++r) { ls[r] = __hip_atomic_fetch_add(lcnt + te[r], 1, __ATOMIC_RELAXED, __HIP_MEMORY_SCOPE_WORKGROUP); WTS[t * 4 + r] = ev[r] * rs; }
            LDS_WAIT();
            __builtin_amdgcn_wave_barrier();
            if (tid < 32) { const int n = lcnt[tid]; lcnt[32 + tid] = n ? (int)__hip_atomic_fetch_add(ctl + CW_GCNT + tid, (unsigned)n, RLX_AGENT) : 0; }
            LDS_WAIT();
            __builtin_amdgcn_wave_barrier();
#pragma unroll
            for (int r = 0; r < 4; ++r) { const int slot = lcnt[32 + te[r]] + ls[r]; TOKL[te[r] * NTOK + slot] = t; SEL[t * 4 + r] = (te[r] << 16) | slot; }
        }
        LDS_WAIT(); __syncthreads();
    }
}

__device__ __forceinline__ void p10_final(const Args& a, LAS int* tab, int vcu, int G) {
    int tid_ = threadIdx.x; asm volatile("" : "+v"(tid_)); const int lane = tid_ & 63, wave = __builtin_amdgcn_readfirstlane(tid_ >> 6);
    const bf16* X1 = (const bf16*)(a.ws + WS_X1); const unsigned char* YB = a.ws + WS_YB; const int* SEL = (const int*)(a.ws + WS_SEL); const float* WTS = (const float*)(a.ws + WS_WTS);
    constexpr int TPT = 4;
    const int gw = vcu * NWAVES + wave, NGW = G * NWAVES;
    f32x4 gn[4];
#pragma unroll
    for (int j = 0; j < 4; ++j) gn[j] = *((const GAS f32x4*)a.norm_final + lane + 64 * j);
    for (int t0 = gw; t0 < NTOK; t0 += TPT * NGW) {
        int sel[TPT][4]; float wt[TPT][4]; int tq[TPT];
#pragma unroll
        for (int q = 0; q < TPT; ++q) { tq[q] = (t0 + q * NGW < NTOK) ? t0 + q * NGW : t0;
#pragma unroll
            for (int k = 0; k < 4; ++k) { sel[q][k] = SEL[tq[q] * 4 + k]; wt[q][k] = WTS[tq[q] * 4 + k] * (1.0f / Y8_SCALE); } }
        f32x4 v[TPT][4]; int yv[TPT][4][4];
#pragma unroll
        for (int q = 0; q < TPT; ++q) { const GAS v2u* xr = (const GAS v2u*)(X1 + (size_t)tq[q] * DM) + lane;
#pragma unroll
            for (int j = 0; j < 4; ++j) { const v2u x2 = xr[64 * j]; v[q][j] = (f32x4){bf2f(x2.x & 0xffffu), bf2f(x2.x >> 16), bf2f(x2.y & 0xffffu), bf2f(x2.y >> 16)}; }
#pragma unroll
            for (int k = 0; k < 4; ++k) { const int e = sel[q][k] >> 16, slot = sel[q][k] & 0xffff;
                const size_t hrow = (size_t)tab[32 + e] * 256 + slot;
                const GAS int* yr = (const GAS int*)(YB + hrow * 1024) + lane;
#pragma unroll
                for (int j = 0; j < 4; ++j) yv[q][k][j] = __builtin_nontemporal_load(&yr[64 * j]); } }
#pragma unroll
        for (int q = 0; q < TPT; ++q) {
#pragma unroll
            for (int k = 0; k < 4; ++k) { const float w = wt[q][k];
#pragma unroll
                for (int j = 0; j < 4; ++j) { const int y = yv[q][k][j];
                    const f32x2 lo = __builtin_amdgcn_cvt_pk_f32_fp8(y, false), hi = __builtin_amdgcn_cvt_pk_f32_fp8(y, true);
                    v[q][j].x += w * lo[0]; v[q][j].y += w * lo[1]; v[q][j].z += w * hi[0]; v[q][j].w += w * hi[1]; } }
            float s = 0.f;
#pragma unroll
            for (int j = 0; j < 4; ++j) s += (v[q][j].x * v[q][j].x + v[q][j].y * v[q][j].y) + (v[q][j].z * v[q][j].z + v[q][j].w * v[q][j].w);
            s = wave_sum(s);
            const float r = rsqrtf(s * (1.f / DM) + EPS);
            if (t0 + q * NGW < NTOK) { GAS f32x4* orow = (GAS f32x4*)(a.out + (size_t)tq[q] * DM) + lane;
#pragma unroll
                for (int j = 0; j < 4; ++j) __builtin_nontemporal_store(v[q][j] * r * gn[j], &orow[64 * j]); } }
    }
}

constexpr int N_PHASES = 11;
__global__ void __launch_bounds__(NWAVES * 64, 2) mk_fwd(Args args) {
    extern __shared__ __attribute__((aligned(16))) unsigned char lds_raw[];
    LAS unsigned char* lds = (LAS unsigned char*)lds_raw;
    volatile LAS unsigned* MISC = (volatile LAS unsigned*)(lds + MISC_OFF);
    LAS int* tab = (LAS int*)(lds + TAB_OFF);
    const int tid = threadIdx.x;
    const int G = gridDim.x; const int bx = blockIdx.x; const int vcu = (G % 8 == 0) ? (bx % 8) * (G / 8) + bx / 8 : bx;
    unsigned char* ws = args.ws;
    gu32* ctl = (gu32*)(ws + WS_CTL);
    for (int u = tid; u < (LDS_BYTES - LDSCTL_OFF) / 4; u += NWAVES * 64) ((LAS unsigned*)(lds + LDSCTL_OFF))[u] = 0u;
    __syncthreads();
    const int lo = args.ph_lo, hi = args.ph_hi;
    const bool multi = (hi - lo) > 1;
    XcdBarrier bar; bar.bar = (unsigned*)(ctl + CW_BAR); bar.x = 0; bar.st = nullptr;
    if (multi) bar = xcd_barrier_post((unsigned*)(ctl + CW_BAR), MISC + 8);
#ifndef MK_ONLY
#define MK_ONLY (-1)
#endif
#define IN(k) ((MK_ONLY < 0 || MK_ONLY == (k)) && lo <= (k) && (k) < hi)
#define BOTH(k) (IN(k) && IN((k) + 1))
#ifdef MK_XBAR
#define SEAM(k) do { if (BOTH(k)) { xcd_barrier(bar); xcd_barrier(bar); } } while (0)
#else
#define SEAM(k) do { if (BOTH(k)) xcd_barrier(bar); } while (0)
#endif

    bf16* PROJ = (bf16*)(ws + WS_PROJ);
#ifndef MK_REPEAT
#define MK_REPEAT 0
#endif
#define RUN(k, ...) do { if (IN(k)) { __VA_ARGS__ if constexpr ((MK_REPEAT >> (k)) & 1) { xcd_barrier(bar); __VA_ARGS__ } SEAM(k); } } while (0)
    RUN(0, { p0_prologue(args, lds, vcu, G); });
    RUN(1, {
        { ProbPlain P{(const bf16*)(ws + WS_XB), (const bf16*)(ws + WS_WIN), DM, DM, 0, 0, DM};
          OrderIn16 S{G, vcu};
          EpiInProj E{PROJ, (bf16*)(ws + WS_KR), (const float*)(ws + WS_RX), (const f32x2*)(ws + WS_CS), (float*)(ws + WS_SSQQ), (float*)(ws + WS_SSQKV), (LAS float*)(lds + EPI_TAB_OFF), 0, 1.f};
          pg8::gemm_phase(lds + RING_OFF, P, S, E);
#ifdef PROBE_CALL1
          xcd_barrier(bar); pg8::gemm_phase(lds + RING_OFF, P, S, E); xcd_barrier(bar);
#endif
        }
        { ProbPlain8 P{ws + WS_XB8, ws + WS_WING8, 512, 512};
          OrderIn8 S{G, vcu};
          EpiInProj E{PROJ, (bf16*)(ws + WS_KR), (const float*)(ws + WS_RX), (const f32x2*)(ws + WS_CS), (float*)(ws + WS_SSQQ), (float*)(ws + WS_SSQKV), (LAS float*)(lds + EPI_TAB_OFF), 8, 1.f / (X8_SCALE * W8_SCALE)};
          pg8::gemm_phase(lds + RING_OFF, P, S, E);
#ifdef PROBE_CALL2
          xcd_barrier(bar); pg8::gemm_phase(lds + RING_OFF, P, S, E); xcd_barrier(bar);
#endif
        }
        { ProbQKV P{PROJ, (const bf16*)(ws + WS_WQ), (const bf16*)(ws + WS_WKV), 256, 256};
          OrderQKV2 S{G, vcu};
          EpiQKV E{(bf16*)(ws + WS_QM), (bf16*)(ws + WS_KN), (bf16*)(ws + WS_VM), (const float*)(ws + WS_SSQQ), (const float*)(ws + WS_SSQKV), (const f32x2*)(ws + WS_CS)};
          pg8::gemm_phase(lds + RING_OFF, P, S, E);
#ifdef PROBE_CALL3
          xcd_barrier(bar); pg8::gemm_phase(lds + RING_OFF, P, S, E); xcd_barrier(bar);
#endif
        } });
    RUN(3, {
        int tid3 = threadIdx.x; asm volatile("" : "+v"(tid3)); const int wave3 = __builtin_amdgcn_readfirstlane(tid3 >> 6), lane3 = tid3 & 63;
        const att::ConvArgs CV{args.w1, args.w2, args.norm_ffn, ws + WS_W1T, ws + WS_W2T, G * NWAVES, 0};
        att::ConvState cs{vcu * NWAVES + wave3, (vcu * NWAVES + wave3) / att::CONV_PER_E, (vcu * NWAVES + wave3) % att::CONV_PER_E, 0, 0, 0};
        for (int p = vcu; p < 512; p += G) {
            const int type = p >> 8, pp = p & 255, hd = pp >> 4, s = pp & 15, b = hd >> 3, hh = hd & 7;
            const size_t r0 = (size_t)b * SEQ;
            if (type == 0) {
                att::AttnP T{(const bf16*)(ws + WS_QM) + r0 * 768 + hh * 96, 768, (const bf16*)(ws + WS_KN) + r0 * 512 + hh * 64, 512, (const bf16*)(ws + WS_KR) + r0 * 32, 32,
                             (const bf16*)(ws + WS_VM) + r0 * 512 + hh * 64, 512, (bf16*)(ws + WS_YC) + r0 * 1024 + hh * 64, 1024, nullptr, 0};
                att::attn_unit<96, 64, false>(T, 31 - s, lds + RING_OFF, CV, cs);
                att::attn_unit<96, 64, false>(T, s, lds + RING_OFF, CV, cs);
            } else {
                att::AttnP T{PROJ + r0 * NPROJ + 512 + hh * 64, NPROJ, PROJ + r0 * NPROJ + 1024 + hh * 64, NPROJ, nullptr, 0,
                             PROJ + r0 * NPROJ + 1536 + (hh >> 1) * 128, NPROJ, (bf16*)(ws + WS_OD) + r0 * 1024 + hh * 128, 1024, args.rel_bias, hh >> 1};
                att::attn_unit<64, 128, true>(T, 31 - s, lds + RING_OFF, CV, cs);
                att::attn_unit<64, 128, true>(T, s, lds + RING_OFF, CV, cs);
            }
        }
#ifdef PROBE_ATT_MODE
        { int tid3b = threadIdx.x; asm volatile("" : "+v"(tid3b)); const int lane3 = tid3b & 63;
          LAS const float* stg_ = (LAS const float*)(lds + RING_OFF + CONV_OFF + wave3 * 4096);
          VM_WAIT();
          if (cs.pending) { att::conv_finish(CV, cs.ce, cs.cr, stg_, lane3); cs.pending = 0; }
          while (cs.next < att::CONV_NITEM) { LDS_WAIT(); att::conv_issue(CV, cs.ne, cs.nr, (unsigned)(uintptr_t)(lds + RING_OFF) + CONV_OFF + wave3 * 4096, lane3); VM_WAIT(); att::conv_finish(CV, cs.ne, cs.nr, stg_, lane3);
              cs.next += CV.stride; cs.nr += CV.stride; while (cs.nr >= att::CONV_PER_E) { cs.nr -= att::CONV_PER_E; ++cs.ne; } } }
        xcd_barrier(bar);
        const att::ConvArgs CV2{args.w1, args.w2, args.norm_ffn, ws + WS_YB, ws + WS_YB + 64 * MiB, G * NWAVES, PROBE_ATT_MODE};
        cs = att::ConvState{vcu * NWAVES + wave3, (vcu * NWAVES + wave3) / att::CONV_PER_E, (vcu * NWAVES + wave3) % att::CONV_PER_E, 0, 0, 0};
        if (PROBE_ATT_MODE == 9) cs.next = att::CONV_NITEM;
#define CV CV2
        for (int p = vcu; p < 512; p += G) {
            const int type = p >> 8, pp = p & 255, hd = pp >> 4, s = pp & 15, b = hd >> 3, hh = hd & 7;
            const size_t r0 = (size_t)b * SEQ;
            if (type == 0) {
                att::AttnP T{(const bf16*)(ws + WS_QM) + r0 * 768 + hh * 96, 768, (const bf16*)(ws + WS_KN) + r0 * 512 + hh * 64, 512, (const bf16*)(ws + WS_KR) + r0 * 32, 32,
                             (const bf16*)(ws + WS_VM) + r0 * 512 + hh * 64, 512, (bf16*)(ws + WS_YC) + r0 * 1024 + hh * 64, 1024, nullptr, 0};
                att::attn_unit<96, 64, false>(T, 31 - s, lds + RING_OFF, CV, cs);
                att::attn_unit<96, 64, false>(T, s, lds + RING_OFF, CV, cs);
            } else {
                att::AttnP T{PROJ + r0 * NPROJ + 512 + hh * 64, NPROJ, PROJ + r0 * NPROJ + 1024 + hh * 64, NPROJ, nullptr, 0,
                             PROJ + r0 * NPROJ + 1536 + (hh >> 1) * 128, NPROJ, (bf16*)(ws + WS_OD) + r0 * 1024 + hh * 128, 1024, args.rel_bias, hh >> 1};
                att::attn_unit<64, 128, true>(T, 31 - s, lds + RING_OFF, CV, cs);
                att::attn_unit<64, 128, true>(T, s, lds + RING_OFF, CV, cs);
            }
        }
#undef CV
#endif
        { int tid3b = threadIdx.x; asm volatile("" : "+v"(tid3b)); const int lane3 = tid3b & 63;
          LAS const float* stg_ = (LAS const float*)(lds + RING_OFF + CONV_OFF + wave3 * 4096);
          VM_WAIT();
          if (cs.pending) { att::conv_finish(CV, cs.ce, cs.cr, stg_, lane3); cs.pending = 0; }
          while (cs.next < att::CONV_NITEM) { LDS_WAIT(); att::conv_issue(CV, cs.ne, cs.nr, (unsigned)(uintptr_t)(lds + RING_OFF) + CONV_OFF + wave3 * 4096, lane3); VM_WAIT(); att::conv_finish(CV, cs.ne, cs.nr, stg_, lane3);
              cs.next += CV.stride; cs.nr += CV.stride; while (cs.nr >= att::CONV_PER_E) { cs.nr -= att::CONV_PER_E; ++cs.ne; } } } });
    RUN(4, { p4_combine(args, vcu, G); });
    RUN(5, {
        pg8::StaticOrder S; S.init(NTOK, DM, G, bx);
        ProbPlain P{(const bf16*)(ws + WS_YC), (const bf16*)(ws + WS_WUP), DM, DM, 0, 0, DM};
        EpiUp E{(bf16*)(ws + WS_MG), PROJ}; pg8::gemm_phase(lds + RING_OFF, P, S, E); });
    RUN(6, {
        ProbPlain P{(const bf16*)(ws + WS_MG), (const bf16*)(ws + WS_WOUT), DM, DM, 0, 0, DM};
        pg8::StaticOrder S; S.init(NTOK, DM, G, bx);
        EpiOut E{args.x, (bf16*)(ws + WS_X1), (float*)(ws + WS_SSQ2)};
        pg8::gemm_phase(lds + RING_OFF, P, S, E); });
    if (IN(7)) { p7_router(args, lds, vcu, G); SEAM(7); }
    RUN(8, {
        int tid8 = threadIdx.x; asm volatile("" : "+v"(tid8));
        build_expert_tab(ctl, tab, tid8);
        LAS unsigned short* tokT = (LAS unsigned short*)(lds + TOKT_OFF);
        EpiExp1 E{ws + WS_HB, args.b1, (LAS float*)(lds + EPI_TAB_OFF)};
        OrderExpert S{tab, 8, G, bx, 0, 1 << 30};
        pg8::Unit uu;
        if (!S.next(TOKT_UNITS, uu)) {
            ProbExp1<true> P{ws + WS_XQ, ws + WS_W1T, (const int*)(ws + WS_TOKL), tab, tokT, 512, 512};
            { const int hi8 = __builtin_amdgcn_readfirstlane(tid8 >> 8), r8 = tid8 & 255; int tk[TOKT_UNITS / 2];
              _Pragma("unroll") for (int k = 0; k < TOKT_UNITS / 2; ++k) { tk[k] = 0; if (S.next(2 * k + hi8, uu)) tk[k] = P.tok_g(uu, r8); }
              _Pragma("unroll") for (int k = 0; k < TOKT_UNITS / 2; ++k) tokT[(2 * k + hi8) * 256 + r8] = (unsigned short)tk[k]; }
            LDS_WAIT(); __syncthreads();
            pg8::gemm_phase(lds + RING_OFF, P, S, E);
        } else { ProbExp1<false> P{ws + WS_XQ, ws + WS_W1T, (const int*)(ws + WS_TOKL), tab, tokT, 512, 512}; pg8::gemm_phase(lds + RING_OFF, P, S, E); } });
    RUN(9, {
        int tid9 = threadIdx.x; asm volatile("" : "+v"(tid9));
        if (lo > 8) build_expert_tab(ctl, tab, tid9);
        ProbExp2 P{ws + WS_HB, ws + WS_W2T, 512, 512};
        OrderExpert S{tab, 4, G, bx, 0, 1 << 30};
        EpiExp2 E{ws + WS_YB, args.b2, (LAS float*)(lds + EPI_TAB_OFF)};
        pg8::gemm_phase(lds + RING_OFF, P, S, E);
#if defined(PROBE_P9_NOEPI) || defined(PROBE_P9_NOMMA)
        xcd_barrier(bar);
        { struct EpiNull { __device__ __forceinline__ void operator()(const f32x4 (&)[2][2][4][2], const pg8::Unit&, int, int, int, int) const {} } EN;
#ifdef PROBE_P9_NOMMA
          pg8::gemm_phase<EpiNull, OrderExpert, ProbExp2, true>(lds + RING_OFF, P, S, EN);
#else
          pg8::gemm_phase(lds + RING_OFF, P, S, EN);
#endif
        }
#endif
        });
    if (IN(10)) { int tid10 = threadIdx.x; asm volatile("" : "+v"(tid10)); if (lo > 8) build_expert_tab(ctl, tab, tid10); p10_final(args, tab, vcu, G); if constexpr ((MK_REPEAT >> 10) & 1) { xcd_barrier(bar); p10_final(args, tab, vcu, G); } }
#undef RUN
#undef IN
#undef BOTH
#undef SEAM
}

extern "C" void kernel_launch(void* const* d_in, const int* in_sizes, int n_in, void* d_out, int out_size, void* d_ws, size_t ws_size, hipStream_t stream) {
    static int grid = 0;
    if (grid == 0) {
        if (n_in != 22 || in_sizes[0] != NTOK * DM || out_size != NTOK * DM || ws_size < WS_END) { fprintf(stderr, "kernel_launch: unexpected shapes (n_in %d, ws %zu)\n", n_in, ws_size); grid = -1; return; }
        int dev = 0, cus = 0, per_cu = 0;
        if (hipGetDevice(&dev) != hipSuccess || hipDeviceGetAttribute(&cus, hipDeviceAttributeMultiprocessorCount, dev) != hipSuccess) { grid = -1; return; }
        if (hipFuncSetAttribute((const void*)mk_fwd, hipFuncAttributeMaxDynamicSharedMemorySize, LDS_BYTES) != hipSuccess) { fprintf(stderr, "kernel_launch: hipFuncSetAttribute failed\n"); grid = -1; return; }
        if (hipOccupancyMaxActiveBlocksPerMultiprocessor(&per_cu, (const void*)mk_fwd, NWAVES * 64, LDS_BYTES) != hipSuccess || per_cu < 1) { fprintf(stderr, "kernel_launch: occupancy query says %d\n", per_cu); }
        (void)hipGetLastError();
        grid = cus;
    }
    if (grid < 0) return;
    if (hipMemsetAsync((char*)d_ws + WS_CTL, 0, CTL_ZERO_BYTES, stream) != hipSuccess) return;
    Args a{};
    a.x = (const float*)d_in[0]; a.pos = (const int*)d_in[1]; a.norm_mix = (const float*)d_in[2]; a.w_in = (const float*)d_in[3]; a.mla_q_norm = (const float*)d_in[4];
    a.w_q_b = (const float*)d_in[5]; a.mla_kv_norm = (const float*)d_in[6]; a.w_kv_b = (const float*)d_in[7]; a.diff_lambda = (const float*)d_in[8]; a.diff_subln = (const float*)d_in[9];
    a.rel_bias = (const float*)d_in[10]; a.w_up_mla = (const float*)d_in[11]; a.w_up_diff = (const float*)d_in[12]; a.w_out = (const float*)d_in[13]; a.norm_ffn = (const float*)d_in[14];
    a.w_router = (const float*)d_in[15]; a.b_router = (const float*)d_in[16]; a.w1 = (const float*)d_in[17]; a.b1 = (const float*)d_in[18]; a.w2 = (const float*)d_in[19];
    a.b2 = (const float*)d_in[20]; a.norm_final = (const float*)d_in[21];
    a.out = (float*)d_out; a.ws = (unsigned char*)d_ws;
#if MK_N_LAUNCHES == 1
    a.ph_lo = 0; a.ph_hi = N_PHASES;
    hipLaunchKernelGGL(mk_fwd, dim3(grid), dim3(NWAVES * 64), LDS_BYTES, stream, a);
#else
    for (int p = 0; p < N_PHASES; ++p) { a.ph_lo = p; a.ph_hi = p + 1; hipLaunchKernelGGL(mk_fwd, dim3(grid), dim3(NWAVES * 64), LDS_BYTES, stream, a); }
#endif
}
```
